# Optimizing an MI355X kernel written in HIP

```python
import math
import jax, jax.numpy as jnp
from jax import lax
import numpy as np

D_MODEL = 1024
BATCH = 4
SEQ = 8192
DEPTH = 2

HEAD_DIM = 64
N_MOBA_HEADS = 6
N_DIFF_HEADS = 6
N_SB_HEADS = 6
DIFF_QK_DIM = HEAD_DIM // 2
MOBA_BLOCK = 256
MOBA_TOPK = 3
MOBA_Q_CHUNK = 64
Q_BLOCK = 128
D_FF = 2816
N_BRANCH = 3
LN_EPS = 1e-5
SUBLN_EPS = 1e-5
MOBA_W = N_MOBA_HEADS * HEAD_DIM
DIFF_QK_W = N_DIFF_HEADS * 2 * DIFF_QK_DIM
DIFF_V_W = N_DIFF_HEADS * HEAD_DIM
SB_W = N_SB_HEADS * HEAD_DIM
IN_SIZES = (MOBA_W, MOBA_W, MOBA_W, DIFF_QK_W, DIFF_QK_W, DIFF_V_W, SB_W, SB_W, SB_W, N_BRANCH * D_MODEL)
N_IN = 3 * MOBA_W + 2 * DIFF_QK_W + DIFF_V_W + 3 * SB_W + N_BRANCH * D_MODEL

kernel_name = "hybrid_moba_diff_stickbreak_deepnorm"

F32 = jnp.float32


def _alibi_slopes(n):
    return (2.0 ** (-8.0 * np.arange(1, n + 1, dtype=np.float32) / n)).astype(np.float32)


def layer_norm(x, g, b):
    xf = x.astype(F32)
    mu = jnp.mean(xf, axis=-1, keepdims=True)
    var = jnp.mean(jnp.square(xf - mu), axis=-1, keepdims=True)
    return ((xf - mu) * lax.rsqrt(var + LN_EPS) * g + b).astype(x.dtype)


def swiglu(x, w_gate, w_up, w_down):
    return (jax.nn.silu(x @ w_gate) * (x @ w_up)) @ w_down


def split_heads(t, n_heads):
    B, S, _ = t.shape
    return t.reshape(B, S, n_heads, -1).transpose(0, 2, 1, 3)


def merge_heads(t):
    B, H, S, d = t.shape
    return t.transpose(0, 2, 1, 3).reshape(B, S, H * d)


def moba_attention(q, k, v, slopes):
    B, H, S, Dh = q.shape
    nb = -(-S // MOBA_BLOCK)
    pad = nb * MOBA_BLOCK - S
    kp = jnp.pad(k, ((0, 0), (0, 0), (0, pad), (0, 0)))
    vp = jnp.pad(v, ((0, 0), (0, 0), (0, pad), (0, 0)))
    kb = kp.reshape(B, H, nb, MOBA_BLOCK, Dh)
    vb = vp.reshape(B, H, nb, MOBA_BLOCK, Dh)
    kmean = jnp.mean(kb.astype(F32), axis=3)
    topk = min(MOBA_TOPK, nb)
    scale = Dh ** -0.5
    bi = jnp.arange(B)[:, None, None, None]
    hi = jnp.arange(H)[None, :, None, None]
    slope = slopes.reshape(1, H, 1, 1)
    blk_off = jnp.arange(MOBA_BLOCK)
    blk_ids = jnp.arange(nb)
    n_chunks = S // MOBA_Q_CHUNK

    def chunk(i):
        t0 = i * MOBA_Q_CHUNK
        qc = lax.dynamic_slice_in_dim(q, t0, MOBA_Q_CHUNK, axis=2)
        tpos = t0 + jnp.arange(MOBA_Q_CHUNK)
        own = t0 // MOBA_BLOCK
        gate = jnp.einsum('bhcd,bhnd->bhcn', qc.astype(F32), kmean)
        gate = jnp.where(blk_ids < own, gate, -jnp.inf)
        _, sel = lax.top_k(gate, topk)
        valid = sel < own
        ksel = kb[bi, hi, sel]
        vsel = vb[bi, hi, sel]
        s_sel = jnp.einsum('bhcd,bhcnkd->bhcnk', qc, ksel).astype(F32) * scale
        dist_sel = tpos[None, None, :, None, None] - (sel[..., None] * MOBA_BLOCK + blk_off)
        s_sel = jnp.where(valid[..., None], s_sel - slope[..., None] * dist_sel, -jnp.inf)
        kown = lax.dynamic_index_in_dim(kb, own, axis=2, keepdims=False)
        vown = lax.dynamic_index_in_dim(vb, own, axis=2, keepdims=False)
        s_own = jnp.einsum('bhcd,bhkd->bhck', qc, kown).astype(F32) * scale
        dist_own = tpos[:, None] - (own * MOBA_BLOCK + blk_off)[None, :]
        s_own = jnp.where(dist_own >= 0, s_own - slope * dist_own, -jnp.inf)
        scores = jnp.concatenate([s_sel.reshape(B, H, MOBA_Q_CHUNK, topk * MOBA_BLOCK), s_own], axis=-1)
        p = jax.nn.softmax(scores, axis=-1).astype(v.dtype)
        p_sel = p[..., :topk * MOBA_BLOCK].reshape(B, H, MOBA_Q_CHUNK, topk, MOBA_BLOCK)
        p_own = p[..., topk * MOBA_BLOCK:]
        return (jnp.einsum('bhcnk,bhcnkd->bhcd', p_sel, vsel)
                + jnp.einsum('bhck,bhkd->bhcd', p_own, vown))

    out = lax.map(chunk, jnp.arange(n_chunks))
    return out.transpose(1, 2, 0, 3, 4).reshape(B, H, S, Dh)


def diff_attention(q, k, v, slopes, lam, subln_g, lambda_init):
    B, H, _, S, dq = q.shape
    dv = v.shape[-1]
    scale = dq ** -0.5
    kpos = jnp.arange(S)
    slope = slopes.reshape(1, H, 1, 1, 1)

    def block(i):
        t0 = i * Q_BLOCK
        qc = lax.dynamic_slice_in_dim(q, t0, Q_BLOCK, axis=3)
        dist = (t0 + jnp.arange(Q_BLOCK))[:, None] - kpos[None, :]
        s = jnp.einsum('bhmcd,bhmsd->bhmcs', qc, k).astype(F32) * scale
        s = jnp.where(dist >= 0, s - slope * dist, -jnp.inf)
        p = jax.nn.softmax(s, axis=-1)
        w = p[:, :, 0] - lam * p[:, :, 1]
        return jnp.einsum('bhcs,bhsd->bhcd', w.astype(v.dtype), v)

    o = lax.map(block, jnp.arange(S // Q_BLOCK))
    o = o.transpose(1, 2, 0, 3, 4).reshape(B, H, S, dv).astype(F32)
    o = o * lax.rsqrt(jnp.mean(jnp.square(o), axis=-1, keepdims=True) + SUBLN_EPS) * subln_g
    return (o * (1.0 - lambda_init)).astype(v.dtype)


def stick_breaking_attention(q, k, v):
    B, H, S, Dh = q.shape
    scale = Dh ** -0.5
    kpos = jnp.arange(S)

    def block(i):
        t0 = i * Q_BLOCK
        qc = lax.dynamic_slice_in_dim(q, t0, Q_BLOCK, axis=2)
        before = kpos[None, :] < (t0 + jnp.arange(Q_BLOCK))[:, None]
        z = jnp.einsum('bhcd,bhsd->bhcs', qc, k).astype(F32) * scale
        log_1m = jnp.where(before, jax.nn.log_sigmoid(-z), 0.0)
        tail = lax.cumsum(log_1m, axis=3, reverse=True) - log_1m
        w = jnp.where(before, jnp.exp(jax.nn.log_sigmoid(z) + tail), 0.0)
        return jnp.einsum('bhcs,bhsd->bhcd', w.astype(v.dtype), v)

    o = lax.map(block, jnp.arange(S // Q_BLOCK))
    return o.transpose(1, 2, 0, 3, 4).reshape(B, H, S, Dh)


def hybrid_mixer(x, w_in, b_gate, diff_lambda, diff_subln_g, w_br_moba, w_br_diff, w_br_sb, w_out, layer_idx):
    B, S, D = x.shape
    h = x @ w_in
    offs = []
    acc = 0
    for n in IN_SIZES[:-1]:
        acc += n
        offs.append(acc)
    q_m, k_m, v_m, q_d, k_d, v_d, q_s, k_s, v_s, g = jnp.split(h, offs, axis=-1)

    slopes = jnp.asarray(_alibi_slopes(N_MOBA_HEADS + N_DIFF_HEADS))
    o_m = moba_attention(split_heads(q_m, N_MOBA_HEADS), split_heads(k_m, N_MOBA_HEADS),
                         split_heads(v_m, N_MOBA_HEADS), slopes[0::2])

    lambda_init = 0.8 - 0.6 * math.exp(-0.3 * layer_idx)
    lf = diff_lambda.astype(F32)
    lam = jnp.exp(jnp.sum(lf[0] * lf[1])) - jnp.exp(jnp.sum(lf[2] * lf[3])) + lambda_init
    qd = q_d.reshape(B, S, N_DIFF_HEADS, 2, DIFF_QK_DIM).transpose(0, 2, 3, 1, 4)
    kd = k_d.reshape(B, S, N_DIFF_HEADS, 2, DIFF_QK_DIM).transpose(0, 2, 3, 1, 4)
    o_d = diff_attention(qd, kd, split_heads(v_d, N_DIFF_HEADS), slopes[1::2], lam, diff_subln_g, lambda_init)

    o_s = stick_breaking_attention(split_heads(q_s, N_SB_HEADS), split_heads(k_s, N_SB_HEADS),
                                   split_heads(v_s, N_SB_HEADS))

    gates = jax.nn.sigmoid((g.reshape(B, S, N_BRANCH, D) + b_gate).astype(F32)).astype(x.dtype)
    merged = (gates[:, :, 0] * (merge_heads(o_m) @ w_br_moba)
              + gates[:, :, 1] * (merge_heads(o_d) @ w_br_diff)
              + gates[:, :, 2] * (merge_heads(o_s) @ w_br_sb))
    return merged @ w_out


def setup_inputs(seed: int = 0) -> dict:
    key = jax.random.key(seed)
    ks = jax.random.split(key, 14)
    D = D_MODEL
    beta = (8.0 * DEPTH) ** -0.25
    nrm = jax.random.normal
    segs = [(MOBA_W, 1.0), (MOBA_W, 1.0), (MOBA_W, beta), (DIFF_QK_W, 1.0), (DIFF_QK_W, 1.0),
            (DIFF_V_W, beta), (SB_W, 1.0), (SB_W, 1.0), (SB_W, beta), (N_BRANCH * D, 1.0)]
    col_scale = jnp.asarray(np.concatenate([np.full(n, s, np.float32) for n, s in segs]))
    return {
        "x": nrm(ks[0], (BATCH, SEQ, D), F32),
        "ln_g": 1.0 + 0.02 * nrm(ks[1], (DEPTH, 3, D), F32),
        "ln_b": 0.02 * nrm(ks[2], (DEPTH, 3, D), F32),
        "ffn_w_gate": nrm(ks[3], (DEPTH, 2, D, D_FF), F32) * D ** -0.5,
        "ffn_w_up": nrm(ks[4], (DEPTH, 2, D, D_FF), F32) * (D ** -0.5 * beta),
        "ffn_w_down": nrm(ks[5], (DEPTH, 2, D_FF, D), F32) * (D_FF ** -0.5 * beta),
        "w_in": nrm(ks[6], (DEPTH, D, N_IN), F32) * D ** -0.5 * col_scale,
        "b_gate": 0.01 * nrm(ks[7], (DEPTH, N_BRANCH, D), F32),
        "diff_lambda": 0.1 * nrm(ks[8], (DEPTH, 4, DIFF_QK_DIM), F32),
        "diff_subln_g": 1.0 + 0.02 * nrm(ks[9], (DEPTH, HEAD_DIM), F32),
        "w_br_moba": nrm(ks[10], (DEPTH, MOBA_W, D), F32) * MOBA_W ** -0.5,
        "w_br_diff": nrm(ks[11], (DEPTH, DIFF_V_W, D), F32) * DIFF_V_W ** -0.5,
        "w_br_sb": nrm(ks[12], (DEPTH, SB_W, D), F32) * SB_W ** -0.5,
        "w_out": nrm(ks[13], (DEPTH, D, D), F32) * (D ** -0.5 * beta),
    }


def reference(x, ln_g, ln_b, ffn_w_gate, ffn_w_up, ffn_w_down, w_in, b_gate, diff_lambda,
              diff_subln_g, w_br_moba, w_br_diff, w_br_sb, w_out):
    alpha = (2.0 * DEPTH) ** 0.25
    for l in range(DEPTH):
        x = layer_norm(alpha * x + 0.5 * swiglu(x, ffn_w_gate[l, 0], ffn_w_up[l, 0], ffn_w_down[l, 0]),
                       ln_g[l, 0], ln_b[l, 0])
        x = layer_norm(alpha * x + hybrid_mixer(x, w_in[l], b_gate[l], diff_lambda[l], diff_subln_g[l],
                                                w_br_moba[l], w_br_diff[l], w_br_sb[l], w_out[l], l),
                       ln_g[l, 1], ln_b[l, 1])
        x = layer_norm(alpha * x + 0.5 * swiglu(x, ffn_w_gate[l, 1], ffn_w_up[l, 1], ffn_w_down[l, 1]),
                       ln_g[l, 2], ln_b[l, 2])
    return x
```

```cpp
#include <hip/hip_runtime.h>
#include <hip/hip_cooperative_groups.h>
#include <cstdio>
#include <cstdint>
#include <cmath>
namespace cg = cooperative_groups;
namespace pg8 {
#define PG8_LAS __attribute__((address_space(3)))
typedef unsigned short bf16_t;
typedef short bf16x8 __attribute__((ext_vector_type(8)));
typedef float f32x4 __attribute__((ext_vector_type(4)));
typedef unsigned u32x4 __attribute__((ext_vector_type(4)));
constexpr int BM = 256, BK = 64, HALF = 128, HTB = HALF * BK * 2  , STAGE_BYTES = 8 * HTB, NXCD = 8, WGM = 8;

__host__ __device__ __forceinline__ int lds_byte(int r, int c) { const int st = (r >> 4) * 2 + (c >> 5), rr = r & 15, cc = c & 31, ob = rr * 64 + cc * 2; return st * 1024 + (ob ^ (((ob >> 9) & 1) << 5)); }
__host__ __device__ __forceinline__ void stage_rc(int b, int& R, int& C) { const int st = b / 1024, sb = b % 1024, swz = sb ^ (((sb >> 9) & 1) << 5); R = (st >> 1) * 16 + swz / 64; C = (st & 1) * 32 + (swz % 64) / 2; }
__host__ __device__ __forceinline__ int perm32(int rho) { const int n = rho >> 4, i = rho & 15; return 8 * (i >> 2) + 4 * n + (i & 3); }

struct Unit { int pm, pn, aoff; };
struct Gemm { const bf16_t* A; const bf16_t* Bt; int M, N, K, lda, ldb; };

struct StaticOrder {
    int nM, nN, nwg, G, c;
    __host__ __device__ void init(int M, int N, int G_, int c_) { nM = M / BM; nN = N / BM; nwg = nM * nN; G = G_; c = c_; }
    __host__ __device__ bool next(int i, Unit& u) const {
        const long L = (long)i * G + c; if (L >= nwg) return false;
        int wgid = (int)L; { const int q = nwg / NXCD, r = nwg % NXCD, xcd = wgid % NXCD, off = wgid / NXCD; wgid = (xcd < r ? xcd * (q + 1) : r * (q + 1) + (xcd - r) * q) + off; }
        const int nig = WGM * nN, gid = wgid / nig, fm = gid * WGM, gsz = (nM - fm) < WGM ? (nM - fm) : WGM;
        u.pm = fm + ((wgid % nig) % gsz); u.pn = (wgid % nig) / gsz; u.aoff = 0; return true;
    }
    __device__ __forceinline__ void a_ready(const Unit&) const {}
    __device__ __forceinline__ void done(const Unit&) const {}
};

typedef float f32x2c_t __attribute__((ext_vector_type(2))); typedef __bf16 bf16x2c_t __attribute__((ext_vector_type(2)));
__device__ __forceinline__ unsigned cvt_pk_bf16(float lo, float hi) { f32x2c_t v = {lo, hi}; bf16x2c_t b = __builtin_convertvector(v, bf16x2c_t); return __builtin_bit_cast(unsigned, b); }
typedef float f32x2 __attribute__((ext_vector_type(2)));
__device__ __forceinline__ float bf2f(unsigned short v) { return __uint_as_float(((unsigned)v) << 16); }
__device__ __forceinline__ float bflo(unsigned v) { return __uint_as_float(v << 16); }
__device__ __forceinline__ float bfhi(unsigned v) { return __uint_as_float(v & 0xffff0000u); }
__device__ __forceinline__ float fast_sigmoid(float v) { return __builtin_amdgcn_rcpf(1.0f + __builtin_amdgcn_exp2f(-1.4426950408889634f * v)); }

struct EpiSwiGLU {
    static constexpr bool PERM = true, AFTER_DRAIN = false;
    bf16_t* H; int ldh;
    __device__ __forceinline__ void operator()(const f32x4 (&acc)[2][2][4][2], const Unit& u, int wr, int wc, int fr, int fq) const {
        const int row0 = u.pm * BM + wr * 64 + fr, col0 = u.pn * HALF + wc * 32 + 8 * fq;
#pragma unroll
        for (int ai = 0; ai < 2; ++ai)
#pragma unroll
            for (int m = 0; m < 4; ++m) {
                bf16_t* rowp = H + (size_t)(row0 + ai * HALF + m * 16) * ldh + col0;
                float h[8];
#pragma unroll
                for (int n = 0; n < 2; ++n)
#pragma unroll
                    for (int i = 0; i < 4; ++i) { const float g = acc[ai][0][m][n][i], up = acc[ai][1][m][n][i]; h[4 * n + i] = g * fast_sigmoid(g) * up; }
                u32x4 w; w.x = cvt_pk_bf16(h[0], h[1]); w.y = cvt_pk_bf16(h[2], h[3]); w.z = cvt_pk_bf16(h[4], h[5]); w.w = cvt_pk_bf16(h[6], h[7]);
                *(u32x4*)rowp = w;
            }
    }
};
struct EpiResid {
    static constexpr bool PERM = false, AFTER_DRAIN = false;
    const float* src; float* out; int ldc; float a, bsc;
    __device__ __forceinline__ void operator()(const f32x4 (&acc)[2][2][4][2], const Unit& u, int wr, int wc, int fr, int fq) const {
        const int row0 = u.pm * BM + wr * 64 + fr, col0 = u.pn * BM + wc * 32 + 4 * fq;
#pragma unroll
        for (int ai = 0; ai < 2; ++ai)
#pragma unroll
            for (int m = 0; m < 4; ++m) {
                const size_t off = (size_t)(row0 + ai * HALF + m * 16) * ldc + col0;
#pragma unroll
                for (int bj = 0; bj < 2; ++bj)
#pragma unroll
                    for (int n = 0; n < 2; ++n) { const f32x4 s = *(const f32x4*)(src + off + bj * HALF + n * 16); *(f32x4*)(out + off + bj * HALF + n * 16) = s * a + acc[ai][bj][m][n] * bsc; }
                if (m & 1) asm volatile("" ::: "memory");
            }
    }
};
struct EpiQKV {
    static constexpr bool PERM = true, AFTER_DRAIN = false;
    bf16_t* QK; bf16_t* VT;
    __device__ __forceinline__ void operator()(const f32x4 (&acc)[2][2][4][2], const Unit& u, int wr, int wc, int fr, int fq) const {
        const int row0 = u.pm * BM + wr * 64 + fr;
        if (u.pn < 9) {
            const int col0 = u.pn * BM + wc * 32 + 8 * fq;
#pragma unroll
            for (int ai = 0; ai < 2; ++ai)
#pragma unroll
                for (int m = 0; m < 4; ++m) { bf16_t* rowp = QK + (size_t)(row0 + ai * HALF + m * 16) * 2304 + col0;
#pragma unroll
                    for (int bj = 0; bj < 2; ++bj) { const f32x4 v0 = acc[ai][bj][m][0], v1 = acc[ai][bj][m][1];
                        u32x4 w; w.x = cvt_pk_bf16(v0[0], v0[1]); w.y = cvt_pk_bf16(v0[2], v0[3]); w.z = cvt_pk_bf16(v1[0], v1[1]); w.w = cvt_pk_bf16(v1[2], v1[3]);
                        *(u32x4*)(rowp + bj * HALF) = w; } }
        } else {
            const int bb = (u.pm * BM) >> 13;
            const int s0 = ((u.pm * BM) & 8191) + wr * 64 + fr;
            const int dd = 32 * (wc & 1) + 8 * fq;
#pragma unroll
            for (int bj = 0; bj < 2; ++bj) {
                const int gh = 4 * (u.pn - 9) + 2 * bj + (wc >> 1);
                if (gh < 18) {
                    const int ty = gh / 6, hh = gh - 6 * ty;
                    bf16_t* base = VT + ((size_t)(((ty * 4 + bb) * 6 + hh) * 64 + dd)) * 8192 + s0;
#pragma unroll
                    for (int ai = 0; ai < 2; ++ai)
#pragma unroll
                        for (int m = 0; m < 4; ++m)
#pragma unroll
                            for (int n = 0; n < 2; ++n) { const f32x4 v = acc[ai][bj][m][n]; const unsigned w0 = cvt_pk_bf16(v[0], v[1]), w1 = cvt_pk_bf16(v[2], v[3]);
                                bf16_t* pp = base + (size_t)(4 * n) * 8192 + ai * HALF + m * 16;
                                pp[0] = (bf16_t)(w0 & 0xffffu); pp[8192] = (bf16_t)(w0 >> 16); pp[2 * 8192] = (bf16_t)(w1 & 0xffffu); pp[3 * 8192] = (bf16_t)(w1 >> 16); }
                }
            }
        }
    }
};
struct EpiGate {
    static constexpr bool PERM = true, AFTER_DRAIN = false;
    bf16_t* G; const float* bias;
    __device__ __forceinline__ void operator()(const f32x4 (&acc)[2][2][4][2], const Unit& u, int wr, int wc, int fr, int fq) const {
        const int row0 = u.pm * BM + wr * 64 + fr, col0 = u.pn * BM + wc * 32 + 8 * fq;
        f32x4 bv[2][2];
#pragma unroll
        for (int bj = 0; bj < 2; ++bj)
#pragma unroll
            for (int n = 0; n < 2; ++n) bv[bj][n] = *(const f32x4*)(bias + col0 + bj * HALF + 4 * n);
#pragma unroll
        for (int ai = 0; ai < 2; ++ai)
#pragma unroll
            for (int m = 0; m < 4; ++m) { bf16_t* rowp = G + (size_t)(row0 + ai * HALF + m * 16) * 3072 + col0;
#pragma unroll
                for (int bj = 0; bj < 2; ++bj) { const f32x4 v0 = acc[ai][bj][m][0] + bv[bj][0], v1 = acc[ai][bj][m][1] + bv[bj][1];
                    u32x4 w; w.x = cvt_pk_bf16(fast_sigmoid(v0[0]), fast_sigmoid(v0[1])); w.y = cvt_pk_bf16(fast_sigmoid(v0[2]), fast_sigmoid(v0[3]));
                    w.z = cvt_pk_bf16(fast_sigmoid(v1[0]), fast_sigmoid(v1[1])); w.w = cvt_pk_bf16(fast_sigmoid(v1[2]), fast_sigmoid(v1[3]));
                    *(u32x4*)(rowp + bj * HALF) = w; } }
    }
};
struct EpiBranch {
    static constexpr bool PERM = true, AFTER_DRAIN = false;
    bf16_t* Mg; const bf16_t* G;
    __device__ __forceinline__ void operator()(const f32x4 (&acc)[2][2][4][2], const Unit& u, int wr, int wc, int fr, int fq) const {
        const int br = u.pn >> 2, pq = u.pn & 3;
        const int row0 = u.pm * BM + wr * 64 + fr, gcol0 = u.pn * BM + wc * 32 + 8 * fq, mcol0 = pq * BM + wc * 32 + 8 * fq;
#pragma unroll
        for (int ai = 0; ai < 2; ++ai)
#pragma unroll
            for (int m = 0; m < 4; ++m) { const size_t r = (size_t)(row0 + ai * HALF + m * 16);
#pragma unroll
                for (int bj = 0; bj < 2; ++bj) {
                    const u32x4 gv = *(const u32x4*)(G + r * 3072 + gcol0 + bj * HALF);
                    bf16_t* mp = Mg + r * 1024 + mcol0 + bj * HALF;
                    const f32x4 v0 = acc[ai][bj][m][0], v1 = acc[ai][bj][m][1];
                    float o[8] = { bflo(gv.x) * v0[0], bfhi(gv.x) * v0[1], bflo(gv.y) * v0[2], bfhi(gv.y) * v0[3], bflo(gv.z) * v1[0], bfhi(gv.z) * v1[1], bflo(gv.w) * v1[2], bfhi(gv.w) * v1[3] };
                    if (br > 0) { const u32x4 ov = *(const u32x4*)mp;
                        o[0] += bflo(ov.x); o[1] += bfhi(ov.x); o[2] += bflo(ov.y); o[3] += bfhi(ov.y); o[4] += bflo(ov.z); o[5] += bfhi(ov.z); o[6] += bflo(ov.w); o[7] += bfhi(ov.w); }
                    u32x4 w; w.x = cvt_pk_bf16(o[0], o[1]); w.y = cvt_pk_bf16(o[2], o[3]); w.z = cvt_pk_bf16(o[4], o[5]); w.w = cvt_pk_bf16(o[6], o[7]);
                    *(u32x4*)mp = w; }
                asm volatile("" ::: "memory"); }
    }
};
struct BranchOrder {
    int G, c;
    __device__ bool next(int i, Unit& u) const {
        const int ti = (i / 3) * G + c, br = i - 3 * (i / 3);
        if (ti >= 512) return false;
        u.pm = ti >> 2; u.pn = br * 4 + (ti & 3); u.aoff = br * 384 * 2; return true;
    }
    __device__ __forceinline__ void a_ready(const Unit&) const {}
    __device__ __forceinline__ void done(const Unit&) const {}
};

template <class Epi, class Sched, bool ALIGN_EPI = false, bool SP2 = false>
__device__ __forceinline__ void gemm_phase(PG8_LAS unsigned char* lds, const Gemm g, const Sched& S, const Epi& E, const int tid_in) {
    int tid = tid_in; asm volatile("" : "+v"(tid));
    const int wid = __builtin_amdgcn_readfirstlane(tid >> 6), lane = tid & 63, wr = wid >> 2, wc = wid & 3, fr = lane & 15, fq = lane >> 4;
    const int K = g.K, nt = K / BK;
    unsigned voffA[2], voffB[2];
#pragma unroll
    for (int i = 0; i < 2; ++i) { int R, C; stage_rc(tid * 16 + i * 8192, R, C); const int Rb = Epi::PERM ? ((R & ~31) + perm32(R & 31)) : R;
        voffA[i] = (unsigned)(R * g.lda + C) * 2u; voffB[i] = (unsigned)(Rb * g.ldb + C) * 2u; }
    const size_t kstep = (size_t)(BK * 2);
    const size_t hstepA = (size_t)HALF * g.lda * 2, hstepB = (size_t)HALF * g.ldb * 2;
    const size_t tstepA = 2 * hstepA, tstepB = 2 * hstepB;
    const unsigned ldsw = (unsigned)wid * 1024u;
    const int aoff = lds_byte(wr * 64 + fr, fq * 8), boff = lds_byte(wc * 32 + fr, fq * 8);
#define PG8_SA(b, h) (((b) * 2 + (h)) * HTB)
#define PG8_SB(b, h) ((4 + (b) * 2 + (h)) * HTB)
#define PG8_STAGE(bufoff, gbase, voff) do { _Pragma("unroll") for (int _i = 0; _i < 2; ++_i) \
        __builtin_amdgcn_global_load_lds((const unsigned*)((const char*)(gbase) + (voff)[_i]), (PG8_LAS unsigned*)(lds + (bufoff) + ldsw + _i * 8192), 16, 0, 0); } while (0)
#define PG8_LDA(dst, b, h) do { _Pragma("unroll") for (int m = 0; m < 4; ++m) _Pragma("unroll") for (int k = 0; k < 2; ++k) dst[m][k] = *(const PG8_LAS bf16x8*)(lds + PG8_SA(b, h) + aoff + m * 2048 + k * 1024); } while (0)
#define PG8_LDB(dst, b, h) do { _Pragma("unroll") for (int n = 0; n < 2; ++n) _Pragma("unroll") for (int k = 0; k < 2; ++k) dst[n][k] = *(const PG8_LAS bf16x8*)(lds + PG8_SB(b, h) + boff + n * 2048 + k * 1024); } while (0)
#define PG8_MMA(ai, bj, At, Bt) do { __builtin_amdgcn_s_setprio(1); _Pragma("unroll") for (int m = 0; m < 4; ++m) _Pragma("unroll") for (int n = 0; n < 2; ++n) _Pragma("unroll") for (int k = 0; k < 2; ++k) \
        acc[ai][bj][m][n] = __builtin_amdgcn_mfma_f32_16x16x32_bf16(Bt[n][k], At[m][k], acc[ai][bj][m][n], 0, 0, 0); __builtin_amdgcn_s_setprio(0); } while (0)
#define PG8_WAIT_V(n) asm volatile("s_waitcnt vmcnt(" #n ")" ::: "memory")
#define PG8_WAIT_L(n) asm volatile("s_waitcnt lgkmcnt(" #n ")" ::: "memory")
#define PG8_BAR __builtin_amdgcn_s_barrier()
#define PG8_SCHED __builtin_amdgcn_sched_barrier(0)
    Unit cur, nxt; int ui = 0;
    if (!S.next(0, cur)) return;
    f32x4 acc[2][2][4][2];
#pragma unroll
    for (int a = 0; a < 2; ++a)
#pragma unroll
        for (int b = 0; b < 2; ++b)
#pragma unroll
            for (int m = 0; m < 4; ++m)
#pragma unroll
                for (int n = 0; n < 2; ++n) acc[a][b][m][n] = (f32x4){0.f, 0.f, 0.f, 0.f};
    bf16x8 At[4][2], B0[2][2], B1[2][2];
    const char* cA = (const char*)g.A + (size_t)cur.pm * tstepA + cur.aoff; const char* cB = (const char*)g.Bt + (size_t)cur.pn * tstepB;
    S.a_ready(cur);
    if constexpr (SP2) {
        PG8_STAGE(PG8_SB(0, 0), cB, voffB); PG8_STAGE(PG8_SB(0, 1), cB + hstepB, voffB); PG8_STAGE(PG8_SA(0, 0), cA, voffA); PG8_STAGE(PG8_SA(0, 1), cA + hstepA, voffA);
        if (wr == 1) PG8_BAR;
        PG8_WAIT_V(2); PG8_BAR;
        PG8_STAGE(PG8_SB(1, 0), cB + kstep, voffB); PG8_STAGE(PG8_SA(1, 0), cA + kstep, voffA); PG8_STAGE(PG8_SB(1, 1), cB + hstepB + kstep, voffB);
        PG8_WAIT_V(6); PG8_BAR;
    } else {
        PG8_STAGE(PG8_SB(0, 0), cB, voffB); PG8_STAGE(PG8_SA(0, 0), cA, voffA); PG8_STAGE(PG8_SB(0, 1), cB + hstepB, voffB); PG8_STAGE(PG8_SA(0, 1), cA + hstepA, voffA);
        if (wr == 1) PG8_BAR;
        PG8_WAIT_V(4); PG8_BAR;
        PG8_STAGE(PG8_SB(1, 0), cB + kstep, voffB); PG8_STAGE(PG8_SA(1, 0), cA + kstep, voffA); PG8_STAGE(PG8_SB(1, 1), cB + hstepB + kstep, voffB);
        PG8_WAIT_V(6); PG8_BAR;
    }
    for (;;) {
        const bool has_next = S.next(ui + 1, nxt);
        const char* nA = has_next ? (const char*)g.A + (size_t)nxt.pm * tstepA + nxt.aoff : cA; const char* nB = has_next ? (const char*)g.Bt + (size_t)nxt.pn * tstepB : cB;
        for (int t = 0; t < nt; t += 2) {
            const bool last = (t == nt - 2);
            const char* a1 = cA + (size_t)(t + 1) * kstep;
            const char* a2 = last ? nA : cA + (size_t)(t + 2) * kstep; const char* b2 = last ? nB : cB + (size_t)(t + 2) * kstep;
            const char* a3 = a2 + kstep; const char* b3 = b2 + kstep;
            if (last && has_next) S.a_ready(nxt);
            if constexpr (SP2) {
            PG8_LDB(B0, 0, 0); PG8_LDB(B1, 0, 1); PG8_SCHED; PG8_LDA(At, 0, 0); PG8_STAGE(PG8_SA(1, 1), a1 + hstepA, voffA);
            PG8_WAIT_V(8); PG8_WAIT_L(0); PG8_BAR; PG8_MMA(0, 0, At, B0); PG8_MMA(0, 1, At, B1); PG8_BAR; PG8_SCHED;
            PG8_LDA(At, 0, 1); PG8_STAGE(PG8_SB(0, 0), b2, voffB); PG8_STAGE(PG8_SB(0, 1), b2 + hstepB, voffB); PG8_STAGE(PG8_SA(0, 0), a2, voffA);
            PG8_WAIT_V(8); PG8_WAIT_L(0); PG8_BAR; PG8_MMA(1, 0, At, B0); PG8_MMA(1, 1, At, B1); PG8_BAR; PG8_SCHED;
            PG8_LDB(B0, 1, 0); PG8_LDB(B1, 1, 1); PG8_SCHED; PG8_LDA(At, 1, 0); PG8_STAGE(PG8_SA(0, 1), a2 + hstepA, voffA);
            PG8_WAIT_V(8); PG8_WAIT_L(0); PG8_BAR; PG8_MMA(0, 0, At, B0); PG8_MMA(0, 1, At, B1); PG8_BAR; PG8_SCHED;
            PG8_LDA(At, 1, 1); PG8_STAGE(PG8_SB(1, 0), b3, voffB); PG8_STAGE(PG8_SB(1, 1), b3 + hstepB, voffB); PG8_STAGE(PG8_SA(1, 0), a3, voffA);
            PG8_WAIT_V(8); PG8_WAIT_L(0); PG8_BAR; PG8_MMA(1, 0, At, B0); PG8_MMA(1, 1, At, B1); PG8_BAR; PG8_SCHED;
            } else {
            PG8_LDB(B0, 0, 0); PG8_SCHED; PG8_LDA(At, 0, 0); PG8_STAGE(PG8_SA(1, 1), a1 + hstepA, voffA);
            PG8_WAIT_L(8); PG8_BAR; PG8_WAIT_L(0); PG8_MMA(0, 0, At, B0); PG8_BAR; PG8_SCHED;
            PG8_LDB(B1, 0, 1); PG8_STAGE(PG8_SB(0, 0), b2, voffB);
            PG8_BAR; PG8_WAIT_L(0); PG8_MMA(0, 1, At, B1); PG8_BAR;
            PG8_LDA(At, 0, 1); PG8_STAGE(PG8_SA(0, 0), a2, voffA);
            PG8_BAR; PG8_WAIT_L(0); PG8_MMA(1, 0, At, B0); PG8_BAR; PG8_SCHED;
            PG8_STAGE(PG8_SB(0, 1), b2 + hstepB, voffB);
            PG8_WAIT_V(6); PG8_BAR; PG8_MMA(1, 1, At, B1); PG8_BAR;
            PG8_LDB(B0, 1, 0); PG8_SCHED; PG8_LDA(At, 1, 0); PG8_STAGE(PG8_SA(0, 1), a2 + hstepA, voffA);
            PG8_WAIT_L(8); PG8_BAR; PG8_WAIT_L(0); PG8_MMA(0, 0, At, B0); PG8_BAR; PG8_SCHED;
            PG8_LDB(B1, 1, 1); PG8_STAGE(PG8_SB(1, 0), b3, voffB);
            PG8_BAR; PG8_WAIT_L(0); PG8_MMA(0, 1, At, B1); PG8_BAR;
            PG8_LDA(At, 1, 1); PG8_STAGE(PG8_SA(1, 0), a3, voffA);
            PG8_BAR; PG8_WAIT_L(0); PG8_MMA(1, 0, At, B0); PG8_BAR; PG8_SCHED;
            PG8_STAGE(PG8_SB(1, 1), b3 + hstepB, voffB);
            PG8_WAIT_V(6); PG8_BAR; PG8_MMA(1, 1, At, B1); PG8_BAR;
            }
        }
        if constexpr (ALIGN_EPI) { if (wr == 0) PG8_BAR; }
        if constexpr (!Epi::AFTER_DRAIN) { int ln_; asm volatile("v_mbcnt_lo_u32_b32 %0, -1, 0\n\tv_mbcnt_hi_u32_b32 %0, -1, %0" : "=v"(ln_)); const int fr_ = ln_ & 15, fq_ = ln_ >> 4; E(acc, cur, wr, wc, fr_, fq_); S.done(cur); }
        if (!has_next) break;
#pragma unroll
        for (int a = 0; a < 2; ++a)
#pragma unroll
            for (int b = 0; b < 2; ++b)
#pragma unroll
                for (int m = 0; m < 4; ++m)
#pragma unroll
                    for (int n = 0; n < 2; ++n) acc[a][b][m][n] = (f32x4){0.f, 0.f, 0.f, 0.f};
        cur = nxt; cA = nA; cB = nB; ++ui;
        if constexpr (ALIGN_EPI) { if (wr == 1) PG8_BAR; }
    }
    PG8_WAIT_V(0);
    if constexpr (!ALIGN_EPI) { if (wr == 0) PG8_BAR; }
    PG8_BAR;
    if constexpr (Epi::AFTER_DRAIN) { E.fused(acc, cur, wr, wc, fr, fq, lds, wid, lane); S.done(cur); }
#undef PG8_SA
#undef PG8_SB
#undef PG8_STAGE
#undef PG8_LDA
#undef PG8_LDB
#undef PG8_MMA
#undef PG8_WAIT_V
#undef PG8_WAIT_L
#undef PG8_BAR
#undef PG8_SCHED
}
}
using pg8::bf16_t; using pg8::bf16x8; using pg8::f32x4; using pg8::u32x4;
typedef float f32x16 __attribute__((ext_vector_type(16)));
typedef unsigned u32x2 __attribute__((ext_vector_type(2)));
#define LAS __attribute__((address_space(3)))
constexpr int NWAVES = 8;
constexpr int DM = 1024, NBATCH = 4, SEQ = 8192, DEPTH = 2, DFF = 2816, NHEADS = 6;
constexpr int M = NBATCH * SEQ;
constexpr int NIN = 6528, NQKVP = 3584, NGATE = 3072, QKP = 2304, OP = 1152;
constexpr float LN_EPS = 1e-5f, SUBLN_EPS = 1e-5f;
constexpr size_t MiB = 1u << 20;
constexpr size_t WS_CTL = 0, CTL_ZERO_BYTES = 4096;
constexpr size_t WS_KMEAN = 256 * 1024;
constexpr size_t WS_WGU = 1 * MiB;
constexpr size_t WS_WD = WS_WGU + 2 * (size_t)5632 * 1024 * 2;
constexpr size_t WS_WIN = WS_WD + 2 * (size_t)1024 * 2816 * 2;
constexpr size_t WS_WBR = WS_WIN + (size_t)6656 * 1024 * 2;
constexpr size_t WS_WOUT = WS_WBR + (size_t)3072 * 384 * 2;
constexpr size_t WS_WEND = WS_WOUT + (size_t)1024 * 1024 * 2;
constexpr size_t WS_XB = 52 * MiB;
constexpr size_t WS_QK = 116 * MiB;
constexpr size_t WS_VT = 260 * MiB;
constexpr size_t WS_O = 332 * MiB;
constexpr size_t WS_MG = 404 * MiB;
constexpr size_t WS_G = 116 * MiB;
constexpr size_t WS_H = 116 * MiB;
constexpr size_t WS_END = 468 * MiB;
static_assert(WS_WEND <= WS_XB && WS_XB + (size_t)M * DM * 2 <= WS_QK && WS_QK + (size_t)M * QKP * 2 <= WS_VT && WS_VT + (size_t)72 * MiB <= WS_O && WS_O + (size_t)M * OP * 2 <= WS_MG && WS_MG + (size_t)M * DM * 2 <= WS_END, "ws map");
static_assert(WS_G + (size_t)M * NGATE * 2 <= WS_O && WS_H + (size_t)M * DFF * 2 <= WS_O, "overlay");
constexpr int LDS_BYTES = pg8::STAGE_BYTES;

struct Args {
    const float *x, *ln_g, *ln_b, *w_gate, *w_up, *w_down, *w_in, *b_gate, *dlam, *subg, *w_brm, *w_brd, *w_brs, *w_out;
    float* out; unsigned char* ws;
};

__device__ __forceinline__ unsigned f2bf(float f) { unsigned u = __builtin_bit_cast(unsigned, f); return (u + 0x7fffu + ((u >> 16) & 1u)) >> 16; }
__device__ __forceinline__ unsigned pk2(float lo, float hi) { return f2bf(lo) | (f2bf(hi) << 16); }
__device__ __forceinline__ float shx(float v, int mask, int lane) { return __int_as_float(__builtin_amdgcn_ds_bpermute((lane ^ mask) << 2, __float_as_int(v))); }
__device__ __forceinline__ float wave_sum(float v, int lane) {
#pragma unroll
    for (int o = 1; o < 64; o <<= 1) v += shx(v, o, lane);
    return v;
}
__device__ __forceinline__ void p0_item(const float* W, int K, int N, bf16_t* WT, int k0, int n0, int drow, LAS float* scr, int lane) {
#pragma unroll 8
    for (int i = 0; i < 32; ++i) { const int kk = 2 * i + (lane >> 5); scr[kk * 33 + (lane & 31)] = W[(size_t)(k0 + kk) * N + n0 + (lane & 31)]; }
    asm volatile("s_waitcnt lgkmcnt(0)" ::: "memory");
    const int c = lane & 7;
#pragma unroll
    for (int j = 0; j < 4; ++j) { const int n = (lane >> 3) + 8 * j; const LAS float* s = scr + (8 * c) * 33 + n;
        u32x4 o; o.x = pk2(s[0 * 33], s[1 * 33]); o.y = pk2(s[2 * 33], s[3 * 33]); o.z = pk2(s[4 * 33], s[5 * 33]); o.w = pk2(s[6 * 33], s[7 * 33]);
        *(u32x4*)(WT + (size_t)(drow + n) * K + k0 + 8 * c) = o; }
    asm volatile("s_waitcnt lgkmcnt(0)" ::: "memory");
}
typedef const __attribute__((address_space(4))) Args* ArgsP;
__device__ __forceinline__ void p0_convert(ArgsP a, unsigned char* ws, int l, LAS unsigned char* lds, int gw, int NGW, int wave, int lane) {
    LAS float* scr = (LAS float*)(lds + wave * 16384);
    constexpr int I_G = 2 * 16 * 88, I_D = 2 * 44 * 32, I_IN = 16 * 204, I_BR = 3 * 6 * 32, I_O = 16 * 32;
    constexpr int NITEMS = 2 * I_G + I_D + I_IN + I_BR + I_O;
    for (int it = gw; it < NITEMS; it += NGW) {
        int r = it;
        if (r < 2 * I_G) {
            const int up = r >= I_G; if (up) r -= I_G;
            const int f = r / (16 * 88); r -= f * (16 * 88);
            const int kb = r / 88, nb = r - kb * 88, n0 = 32 * nb;
            const float* W = (up ? a->w_up : a->w_gate) + (size_t)(l * 2 + f) * DM * DFF;
            bf16_t* WT = (bf16_t*)(ws + WS_WGU) + (size_t)f * 5632 * 1024;
            p0_item(W, DM, DFF, WT, 64 * kb, n0, 256 * (n0 >> 7) + 128 * up + (n0 & 127), scr, lane);
            continue;
        }
        r -= 2 * I_G;
        if (r < I_D) {
            const int f = r / (44 * 32); r -= f * (44 * 32);
            const int kb = r / 32, nb = r - kb * 32;
            p0_item(a->w_down + (size_t)(l * 2 + f) * DFF * DM, DFF, DM, (bf16_t*)(ws + WS_WD) + (size_t)f * 1024 * 2816, 64 * kb, 32 * nb, 32 * nb, scr, lane);
            continue;
        }
        r -= I_D;
        if (r < I_IN) {
            const int kb = r / 204, nb = r - kb * 204, n0 = 32 * nb;
            int drow;
            if (n0 < 3456) { const int seg = n0 / 384, rem = n0 - seg * 384, ty = seg / 3, qkv = seg - 3 * ty; drow = (qkv < 2 ? ty * 768 + qkv * 384 : 2304 + ty * 384) + rem; }
            else drow = n0 + 128;
            p0_item(a->w_in + (size_t)l * DM * NIN, DM, NIN, (bf16_t*)(ws + WS_WIN), 64 * kb, n0, drow, scr, lane);
            continue;
        }
        r -= I_IN;
        if (r < I_BR) {
            const int br = r / (6 * 32); r -= br * (6 * 32);
            const int kb = r / 32, nb = r - kb * 32;
            const float* W = (br == 0 ? a->w_brm : (br == 1 ? a->w_brd : a->w_brs)) + (size_t)l * 384 * DM;
            p0_item(W, 384, DM, (bf16_t*)(ws + WS_WBR), 64 * kb, 32 * nb, br * 1024 + 32 * nb, scr, lane);
            continue;
        }
        r -= I_BR;
        { const int kb = r / 32, nb = r - kb * 32;
          p0_item(a->w_out + (size_t)l * DM * DM, DM, DM, (bf16_t*)(ws + WS_WOUT), 64 * kb, 32 * nb, 32 * nb, scr, lane); }
    }
    if (l == 0) {
        bf16_t* XB = (bf16_t*)(ws + WS_XB);
        for (int m = gw; m < M; m += NGW) {
            const f32x4* xr = (const f32x4*)(a->x + (size_t)m * DM) + lane; u32x2* o8 = (u32x2*)(XB + (size_t)m * DM) + lane;
#pragma unroll
            for (int j = 0; j < 4; ++j) { const f32x4 v = xr[64 * j]; u32x2 w; w.x = pk2(v.x, v.y); w.y = pk2(v.z, v.w); o8[64 * j] = w; }
        }
    }
}
__device__ __forceinline__ void ln_phase(float* out, bf16_t* XB, const float* g, const float* b, int gw, int NGW, int lane) {
    f32x4 gv[4], bv[4];
#pragma unroll
    for (int j = 0; j < 4; ++j) { gv[j] = ((const f32x4*)g)[lane + 64 * j]; bv[j] = ((const f32x4*)b)[lane + 64 * j]; }
    for (int m = gw; m < M; m += NGW) {
        f32x4* xr = (f32x4*)(out + (size_t)m * DM) + lane; u32x2* o8 = (u32x2*)(XB + (size_t)m * DM) + lane;
        f32x4 v[4]; float s = 0.f;
#pragma unroll
        for (int j = 0; j < 4; ++j) { v[j] = xr[64 * j]; s += (v[j].x + v[j].y) + (v[j].z + v[j].w); }
        const float mean = wave_sum(s, lane) * (1.f / DM); float s2 = 0.f;
#pragma unroll
        for (int j = 0; j < 4; ++j) { v[j] = v[j] - mean; s2 += (v[j].x * v[j].x + v[j].y * v[j].y) + (v[j].z * v[j].z + v[j].w * v[j].w); }
        const float rstd = 1.f / sqrtf(wave_sum(s2, lane) * (1.f / DM) + LN_EPS);
#pragma unroll
        for (int j = 0; j < 4; ++j) { const f32x4 y = v[j] * rstd * gv[j] + bv[j]; xr[64 * j] = y; u32x2 w; w.x = pk2(y.x, y.y); w.y = pk2(y.z, y.w); o8[64 * j] = w; }
    }
}
__device__ __forceinline__ void kmean_phase(const bf16_t* QK, float* kmean, int gw, int NGW, int lane) {
    for (int it = gw; it < NBATCH * NHEADS * 32; it += NGW) {
        const int n = it & 31, bh = it >> 5, b = bh / NHEADS, h = bh - b * NHEADS;
        const bf16_t* kp = QK + ((size_t)b * SEQ + (size_t)n * 256) * QKP + 384 + h * 64 + lane;
        float s = 0.f;
#pragma unroll 8
        for (int i = 0; i < 256; ++i) s += pg8::bf2f(kp[(size_t)i * QKP]);
        kmean[(size_t)it * 64 + lane] = s * (1.f / 256.f);
    }
}
#define MFMA32(a, b, c) __builtin_amdgcn_mfma_f32_32x32x16_bf16((a), (b), (c), 0, 0, 0)
using pg8::cvt_pk_bf16;
__device__ __forceinline__ bf16x8 ld8(const bf16_t* p) { return *(const bf16x8*)p; }
__device__ __forceinline__ int swap23(int i) { return (i & ~12) | ((i & 4) << 1) | ((i & 8) >> 1); }
template <int ST> __device__ __forceinline__ bf16x8 pack8(const f32x16& x) {
    u32x4 p; p.x = cvt_pk_bf16(x[8 * ST + 0], x[8 * ST + 1]); p.y = cvt_pk_bf16(x[8 * ST + 2], x[8 * ST + 3]); p.z = cvt_pk_bf16(x[8 * ST + 4], x[8 * ST + 5]); p.w = cvt_pk_bf16(x[8 * ST + 6], x[8 * ST + 7]);
    return __builtin_bit_cast(bf16x8, p);
}
__device__ __forceinline__ f32x16 zero16() { f32x16 z;
#pragma unroll
    for (int r = 0; r < 16; ++r) z[r] = 0.f;
    return z; }
__device__ __forceinline__ int keyof(int r, int hi) { return 16 * (r >> 3) + 8 * hi + (r & 7); }
struct AttnP { const bf16_t* QK; const bf16_t* VT; bf16_t* O; const float* kmean; const float* dlam; const float* subg; unsigned* ctr; int layer; };

__device__ __forceinline__ void sm_update(f32x16& s, float& m, float& l, f32x16 (&o)[2], int lane) {
    float mt = s[0];
#pragma unroll
    for (int r = 1; r < 16; ++r) mt = fmaxf(mt, s[r]);
    mt = fmaxf(mt, shx(mt, 32, lane));
    const float mn = fmaxf(m, mt);
    const float mref = (mn == -INFINITY) ? 0.f : mn;
    const float corr = __builtin_amdgcn_exp2f(m - mref);
    m = mn;
    float ps = 0.f;
#pragma unroll
    for (int r = 0; r < 16; ++r) { s[r] = __builtin_amdgcn_exp2f(s[r] - mref); ps += s[r]; }
    l = l * corr + ps;
    if (__builtin_amdgcn_ballot_w64(corr != 1.0f) != 0ull) {
#pragma unroll
        for (int r = 0; r < 16; ++r) { o[0][r] *= corr; o[1][r] *= corr; }
    }
}
__device__ __forceinline__ void pv_acc(f32x16 (&o)[2], const bf16x8 (&v)[4], const bf16x8 p0, const bf16x8 p1) {
    o[0] = MFMA32(v[0], p0, o[0]); o[0] = MFMA32(v[1], p1, o[0]);
    o[1] = MFMA32(v[2], p0, o[1]); o[1] = MFMA32(v[3], p1, o[1]);
}
__device__ __forceinline__ void ldv(bf16x8 (&v)[4], const bf16_t* VTb, int kt0, int j, int hi) {
    const bf16_t* vp = VTb + (size_t)j * SEQ + kt0 + hi * 8;
    v[0] = ld8(vp); v[1] = ld8(vp + 16); v[2] = ld8(vp + (size_t)32 * SEQ); v[3] = ld8(vp + (size_t)32 * SEQ + 16);
}
__device__ __forceinline__ void store_o(bf16_t* orow, const f32x16 (&o)[2], int hi) {
#pragma unroll
    for (int db = 0; db < 2; ++db)
#pragma unroll
        for (int g = 0; g < 4; ++g) { u32x2 w; w.x = cvt_pk_bf16(o[db][4 * g], o[db][4 * g + 1]); w.y = cvt_pk_bf16(o[db][4 * g + 2], o[db][4 * g + 3]);
            *(u32x2*)(orow + 32 * db + 8 * g + 4 * hi) = w; }
}

__device__ __forceinline__ void moba_unit(const AttnP& p, int b, int h, int qt, int lane) {
    const int j = lane & 31, hi = lane >> 5, t0 = qt * 32, own = t0 >> 8, t = t0 + j, kr = swap23(j);
    const size_t rowb = (size_t)b * SEQ;
    const bf16_t* Qp = p.QK + (rowb + t) * QKP + h * 64;
    const bf16_t* Kb = p.QK + rowb * QKP + 384 + h * 64 + hi * 8;
    const bf16_t* VTb = p.VT + ((size_t)((0 * 4 + b) * 6 + h) * 64) * SEQ;
    bf16x8 qf[4];
#pragma unroll
    for (int ks = 0; ks < 4; ++ks) qf[ks] = ld8(Qp + ks * 16 + hi * 8);
    float v0 = -INFINITY, v1 = -INFINITY, v2 = -INFINITY; int i0 = -1, i1 = -1, i2 = -1;
    if (own > 0) {
        float qv[32];
#pragma unroll
        for (int c = 0; c < 4; ++c) { const u32x4 w = *(const u32x4*)(Qp + 32 * hi + 8 * c);
            qv[8 * c + 0] = pg8::bflo(w.x); qv[8 * c + 1] = pg8::bfhi(w.x); qv[8 * c + 2] = pg8::bflo(w.y); qv[8 * c + 3] = pg8::bfhi(w.y);
            qv[8 * c + 4] = pg8::bflo(w.z); qv[8 * c + 5] = pg8::bfhi(w.z); qv[8 * c + 6] = pg8::bflo(w.w); qv[8 * c + 7] = pg8::bfhi(w.w); }
        const float* km = p.kmean + ((size_t)(b * NHEADS + h) * 32) * 64 + 32 * hi;
        for (int n = 0; n < own; ++n) {
            float g = 0.f;
#pragma unroll
            for (int c = 0; c < 8; ++c) { const f32x4 kv = *(const f32x4*)(km + n * 64 + 4 * c);
                g += qv[4 * c] * kv.x; g += qv[4 * c + 1] * kv.y; g += qv[4 * c + 2] * kv.z; g += qv[4 * c + 3] * kv.w; }
            g += shx(g, 32, lane);
            if (g > v0) { v2 = v1; i2 = i1; v1 = v0; i1 = i0; v0 = g; i0 = n; }
            else if (g > v1) { v2 = v1; i2 = i1; v1 = g; i1 = n; }
            else if (g > v2) { v2 = g; i2 = n; }
        }
    }
    const float c1 = 0.125f * 1.4426950408889634f;
    const float sl2 = __builtin_amdgcn_exp2f(-8.0f * (float)(2 * h + 1) / 12.0f) * 1.4426950408889634f;
    float m = -INFINITY, l = 0.f; f32x16 o[2]; o[0] = zero16(); o[1] = zero16();
    for (int kt0 = t0; kt0 >= own * 256; kt0 -= 32) {
        const bf16_t* kp = Kb + (size_t)(kt0 + kr) * QKP;
        const bf16x8 k0 = ld8(kp), k1 = ld8(kp + 16), k2 = ld8(kp + 32), k3 = ld8(kp + 48);
        bf16x8 v[4]; ldv(v, VTb, kt0, j, hi);
        f32x16 s = zero16();
        s = MFMA32(k0, qf[0], s); s = MFMA32(k1, qf[1], s); s = MFMA32(k2, qf[2], s); s = MFMA32(k3, qf[3], s);
#pragma unroll
        for (int r = 0; r < 16; ++r) { const int dist = t - (kt0 + keyof(r, hi)); s[r] = dist >= 0 ? s[r] * c1 - sl2 * (float)dist : -INFINITY; }
        sm_update(s, m, l, o, lane);
        pv_acc(o, v, pack8<0>(s), pack8<1>(s));
    }
    for (int n = 0; n < own; ++n) {
        const bool sel = (n == i0) || (n == i1) || (n == i2);
        if (__builtin_amdgcn_ballot_w64(sel) == 0ull) continue;
        for (int kt0 = n * 256; kt0 < n * 256 + 256; kt0 += 32) {
            const bf16_t* kp = Kb + (size_t)(kt0 + kr) * QKP;
            const bf16x8 k0 = ld8(kp), k1 = ld8(kp + 16), k2 = ld8(kp + 32), k3 = ld8(kp + 48);
            bf16x8 v[4]; ldv(v, VTb, kt0, j, hi);
            f32x16 s = zero16();
            s = MFMA32(k0, qf[0], s); s = MFMA32(k1, qf[1], s); s = MFMA32(k2, qf[2], s); s = MFMA32(k3, qf[3], s);
#pragma unroll
            for (int r = 0; r < 16; ++r) { const int dist = t - (kt0 + keyof(r, hi)); s[r] = sel ? s[r] * c1 - sl2 * (float)dist : -INFINITY; }
            sm_update(s, m, l, o, lane);
            pv_acc(o, v, pack8<0>(s), pack8<1>(s));
        }
    }
    l += shx(l, 32, lane);
    const float inv = 1.0f / l;
#pragma unroll
    for (int r = 0; r < 16; ++r) { o[0][r] *= inv; o[1][r] *= inv; }
    store_o(p.O + (rowb + t) * OP + 0 * 384 + h * 64, o, hi);
}

__device__ __forceinline__ void diff_unit(const AttnP& p, int b, int h, int qt, int lane, float lam, float lambda_init) {
    const int j = lane & 31, hi = lane >> 5, t0 = qt * 32, t = t0 + j, kr = swap23(j);
    const size_t rowb = (size_t)b * SEQ;
    const bf16_t* Qp = p.QK + (rowb + t) * QKP + 768 + h * 64 + hi * 8;
    const bf16_t* Kb = p.QK + rowb * QKP + 1152 + h * 64 + hi * 8;
    const bf16_t* VTb = p.VT + ((size_t)((1 * 4 + b) * 6 + h) * 64) * SEQ;
    const bf16x8 qa0 = ld8(Qp), qa1 = ld8(Qp + 16), qb0 = ld8(Qp + 32), qb1 = ld8(Qp + 48);
    const float c1 = 0.17677669529663687f * 1.4426950408889634f;
    const float sl2 = __builtin_amdgcn_exp2f(-8.0f * (float)(2 * h + 2) / 12.0f) * 1.4426950408889634f;
    float m1 = -INFINITY, l1 = 0.f, m2 = -INFINITY, l2 = 0.f;
    f32x16 o1[2], o2[2]; o1[0] = zero16(); o1[1] = zero16(); o2[0] = zero16(); o2[1] = zero16();
    for (int kt0 = t0; kt0 >= 0; kt0 -= 32) {
        const bf16_t* kp = Kb + (size_t)(kt0 + kr) * QKP;
        const bf16x8 ka0 = ld8(kp), ka1 = ld8(kp + 16), kb0 = ld8(kp + 32), kb1 = ld8(kp + 48);
        bf16x8 v[4]; ldv(v, VTb, kt0, j, hi);
        const float dl = (float)(t - kt0 - 8 * hi);
        {
            f32x16 s1 = zero16();
            s1 = MFMA32(ka0, qa0, s1); s1 = MFMA32(ka1, qa1, s1);
#pragma unroll
            for (int r = 0; r < 16; ++r) { const float dd = dl - (float)(16 * (r >> 3) + (r & 7)); s1[r] = (dd >= 0.f) ? s1[r] * c1 - sl2 * dd : -INFINITY; }
            sm_update(s1, m1, l1, o1, lane);
            pv_acc(o1, v, pack8<0>(s1), pack8<1>(s1));
        }
        __builtin_amdgcn_sched_barrier(0);
        {
            f32x16 s2 = zero16();
            s2 = MFMA32(kb0, qb0, s2); s2 = MFMA32(kb1, qb1, s2);
#pragma unroll
            for (int r = 0; r < 16; ++r) { const float dd = dl - (float)(16 * (r >> 3) + (r & 7)); s2[r] = (dd >= 0.f) ? s2[r] * c1 - sl2 * dd : -INFINITY; }
            sm_update(s2, m2, l2, o2, lane);
            pv_acc(o2, v, pack8<0>(s2), pack8<1>(s2));
        }
    }
    l1 += shx(l1, 32, lane); l2 += shx(l2, 32, lane);
    const float i1 = 1.0f / l1, i2 = lam / l2;
    float ss = 0.f;
#pragma unroll
    for (int r = 0; r < 16; ++r) { o1[0][r] = o1[0][r] * i1 - o2[0][r] * i2; o1[1][r] = o1[1][r] * i1 - o2[1][r] * i2; ss += o1[0][r] * o1[0][r] + o1[1][r] * o1[1][r]; }
    ss += shx(ss, 32, lane);
    const float rn = (1.0f / sqrtf(ss * (1.0f / 64.0f) + SUBLN_EPS)) * (1.0f - lambda_init);
#pragma unroll
    for (int db = 0; db < 2; ++db)
#pragma unroll
        for (int g = 0; g < 4; ++g) { const f32x4 gv = *(const f32x4*)(p.subg + 32 * db + 8 * g + 4 * hi);
            o1[db][4 * g] *= rn * gv.x; o1[db][4 * g + 1] *= rn * gv.y; o1[db][4 * g + 2] *= rn * gv.z; o1[db][4 * g + 3] *= rn * gv.w; }
    store_o(p.O + (rowb + t) * OP + 1 * 384 + h * 64, o1, hi);
}

__device__ __forceinline__ void sb_unit(const AttnP& p, int b, int h, int qt, int lane) {
    const int j = lane & 31, hi = lane >> 5, t0 = qt * 32, t = t0 + j, kr = swap23(j);
    const size_t rowb = (size_t)b * SEQ;
    const bf16_t* Qp = p.QK + (rowb + t) * QKP + 1536 + h * 64 + hi * 8;
    const bf16_t* Kb = p.QK + rowb * QKP + 1920 + h * 64 + hi * 8;
    const bf16_t* VTb = p.VT + ((size_t)((2 * 4 + b) * 6 + h) * 64) * SEQ;
    bf16x8 qf[4];
#pragma unroll
    for (int ks = 0; ks < 4; ++ks) qf[ks] = ld8(Qp + ks * 16);
    f32x16 o[2]; o[0] = zero16(); o[1] = zero16();
    float R = 0.f;
    for (int kt0 = t0; kt0 >= 0; kt0 -= 32) {
        const bf16_t* kp = Kb + (size_t)(kt0 + kr) * QKP;
        const bf16x8 k0 = ld8(kp), k1 = ld8(kp + 16), k2 = ld8(kp + 32), k3 = ld8(kp + 48);
        bf16x8 v[4]; ldv(v, VTb, kt0, j, hi);
        f32x16 z = zero16();
        z = MFMA32(k0, qf[0], z); z = MFMA32(k1, qf[1], z); z = MFMA32(k2, qf[2], z); z = MFMA32(k3, qf[3], z);
        f32x16 L;
        float g0 = 0.f, g1 = 0.f;
#pragma unroll
        for (int r = 0; r < 16; ++r) {
            const bool valid = (kt0 + keyof(r, hi)) < t;
            const float zz = z[r] * 0.125f;
            const float e = __builtin_amdgcn_exp2f(-1.4426950408889634f * fabsf(zz));
            const float lg = fminf(-zz, 0.f) - 0.6931471805599453f * __builtin_amdgcn_logf(1.0f + e);
            L[r] = valid ? lg : 0.f; z[r] = zz;
            if (r < 8) g0 += L[r]; else g1 += L[r];
        }
        const float og0 = shx(g0, 32, lane), og1 = shx(g1, 32, lane);
        float run1 = R + (hi == 0 ? og1 : 0.f);
        float run0 = R + g1 + og1 + (hi == 0 ? og0 : 0.f);
#pragma unroll
        for (int e = 7; e >= 0; --e) {
            run0 += L[e];     { const bool valid = (kt0 + keyof(e, hi)) < t;     z[e]     = valid ? __builtin_amdgcn_exp2f(1.4426950408889634f * (z[e] + run0)) : 0.f; }
            run1 += L[8 + e]; { const bool valid = (kt0 + keyof(8 + e, hi)) < t; z[8 + e] = valid ? __builtin_amdgcn_exp2f(1.4426950408889634f * (z[8 + e] + run1)) : 0.f; }
        }
        pv_acc(o, v, pack8<0>(z), pack8<1>(z));
        R += (g0 + g1) + (og0 + og1);
        if (__builtin_amdgcn_ballot_w64(R > -100.0f) == 0ull) break;
    }
    store_o(p.O + (rowb + t) * OP + 2 * 384 + h * 64, o, hi);
}

__device__ __forceinline__ void attn_phase(const AttnP& p, int lane, int bx) {
    const float* lf = p.dlam;
    float pa = (lane < 32) ? lf[lane] * lf[32 + lane] : 0.f, pb = (lane < 32) ? lf[64 + lane] * lf[96 + lane] : 0.f;
    pa = wave_sum(pa, lane); pb = wave_sum(pb, lane);
    const float lambda_init = 0.8f - 0.6f * expf(-0.3f * (float)p.layer);
    const float lam = expf(pa) - expf(pb) + lambda_init;
    const int x0 = bx & 7;
    for (int k = 0; k < 8; ++k) {
        const int xq = (x0 + k) & 7;
        unsigned* ctr = p.ctr + 64 * xq;
        for (;;) {
            unsigned u = 0;
            if (lane == 0) u = atomicAdd(ctr, 1u);
            u = (unsigned)__builtin_amdgcn_readfirstlane((int)u);
            if (u >= 9u * 256u) break;
            const int seg = (int)(u >> 8), qt = 255 - (int)(u & 255u);
            const int tyo = seg / 3, bh = xq + 8 * (seg - 3 * tyo), b = bh / NHEADS, h = bh - b * NHEADS;
            if (tyo == 0) diff_unit(p, b, h, qt, lane, lam, lambda_init);
            else if (tyo == 1) moba_unit(p, b, h, qt, lane);
            else sb_unit(p, b, h, qt, lane);
        }
    }
}
__global__ void __launch_bounds__(NWAVES * 64, 2) mega_fwd(Args a) {
    extern __shared__ __attribute__((aligned(16))) unsigned char lds_raw[];
    LAS unsigned char* lds = (LAS unsigned char*)lds_raw;
    cg::grid_group grid = cg::this_grid();
    const int G = gridDim.x, NGW = G * NWAVES;
    const float alpha = 1.4142135623730951f;
#pragma unroll 1
    for (int ph = 0; ph < 14 * DEPTH; ++ph) {
        const int l = ph / 14, k = ph - 14 * l;
        int tid = threadIdx.x; asm volatile("" : "+v"(tid));
        int bx = blockIdx.x; asm volatile("" : "+s"(bx));
        const int lane = tid & 63, wave = __builtin_amdgcn_readfirstlane(tid >> 6), gw = bx * NWAVES + wave;
        ArgsP ap = (ArgsP)__builtin_amdgcn_kernarg_segment_ptr(); asm volatile("" : "+s"(ap));
        unsigned char* ws = ap->ws;
        bf16_t* XB = (bf16_t*)(ws + WS_XB); bf16_t* QK = (bf16_t*)(ws + WS_QK); bf16_t* VT = (bf16_t*)(ws + WS_VT); bf16_t* OB = (bf16_t*)(ws + WS_O);
        bf16_t* MG = (bf16_t*)(ws + WS_MG); bf16_t* GB = (bf16_t*)(ws + WS_G); bf16_t* HB = (bf16_t*)(ws + WS_H);
        bf16_t* Wgu = (bf16_t*)(ws + WS_WGU); bf16_t* Wd = (bf16_t*)(ws + WS_WD); bf16_t* Win = (bf16_t*)(ws + WS_WIN); bf16_t* Wbr = (bf16_t*)(ws + WS_WBR); bf16_t* Wout = (bf16_t*)(ws + WS_WOUT);
        float* kmean = (float*)(ws + WS_KMEAN); unsigned* ctl = (unsigned*)(ws + WS_CTL);
        if (k == 0) {
            p0_convert(ap, ws, l, lds, gw, NGW, wave, lane);
        } else if (k == 1 || k == 11) {
            const int f = (k == 11);
            pg8::Gemm g{XB, Wgu + (size_t)f * 5632 * 1024, M, 5632, DM, DM, DM}; pg8::StaticOrder S; S.init(M, 5632, G, bx);
            pg8::EpiSwiGLU E{HB, DFF};
            pg8::gemm_phase<pg8::EpiSwiGLU, pg8::StaticOrder, true, true>(lds, g, S, E, tid);
        } else if (k == 2 || k == 9 || k == 12) {
            pg8::Gemm g; float beta; const float* src = ap->out;
            if (k == 9) { g = pg8::Gemm{MG, Wout, M, DM, DM, DM, DM}; beta = 1.0f; }
            else { const int f = (k == 12); g = pg8::Gemm{HB, Wd + (size_t)f * 1024 * 2816, M, DM, DFF, DFF, DFF}; beta = 0.5f; if (l == 0 && k == 2) src = ap->x; }
            pg8::StaticOrder S; S.init(M, DM, G, bx);
            pg8::EpiResid E{src, ap->out, DM, alpha, beta};
            pg8::gemm_phase<pg8::EpiResid, pg8::StaticOrder, true, true>(lds, g, S, E, tid);
        } else if (k == 3 || k == 10 || k == 13) {
            const int sub = (k == 3) ? 0 : (k == 10 ? 1 : 2);
            ln_phase(ap->out, XB, ap->ln_g + (size_t)(l * 3 + sub) * DM, ap->ln_b + (size_t)(l * 3 + sub) * DM, gw, NGW, lane);
        } else if (k == 4) {
            pg8::Gemm g{XB, Win, M, NQKVP, DM, DM, DM}; pg8::StaticOrder S; S.init(M, NQKVP, G, bx);
            pg8::EpiQKV E{QK, VT};
            pg8::gemm_phase<pg8::EpiQKV, pg8::StaticOrder, true, true>(lds, g, S, E, tid);
        } else if (k == 5) {
            kmean_phase(QK, kmean, gw, NGW, lane);
        } else if (k == 6) {
            AttnP p{QK, VT, OB, kmean, ap->dlam + (size_t)l * 128, ap->subg + (size_t)l * 64, ctl + 512 * l, l};
            attn_phase(p, lane, bx);
        } else if (k == 7) {
            pg8::Gemm g{XB, Win + (size_t)NQKVP * 1024, M, NGATE, DM, DM, DM}; pg8::StaticOrder S; S.init(M, NGATE, G, bx);
            pg8::EpiGate E{GB, ap->b_gate + (size_t)l * NGATE};
            pg8::gemm_phase<pg8::EpiGate, pg8::StaticOrder, true, true>(lds, g, S, E, tid);
        } else if (k == 8) {
            pg8::Gemm g{OB, Wbr, M, NGATE, 384, OP, 384}; pg8::BranchOrder S{G, bx};
            pg8::EpiBranch E{MG, GB};
            pg8::gemm_phase<pg8::EpiBranch, pg8::BranchOrder, true, true>(lds, g, S, E, tid);
        }
        asm volatile("s_waitcnt vmcnt(0)" ::: "memory");
        __builtin_amdgcn_fence(__ATOMIC_RELEASE, "agent");
        asm volatile("s_waitcnt vmcnt(0)" ::: "memory");
        grid.sync();
        __builtin_amdgcn_fence(__ATOMIC_ACQUIRE, "agent");
        asm volatile("s_waitcnt vmcnt(0)" ::: "memory");
    }
}

extern "C" void kernel_launch(void* const* d_in, const int* in_sizes, int n_in, void* d_out, int out_size, void* d_ws, size_t ws_size, hipStream_t stream) {
    static int grid = 0;
    if (grid == 0) {
        if (n_in != 14 || in_sizes[0] != M * DM || out_size != M * DM || ws_size < WS_END) { fprintf(stderr, "kernel_launch: unexpected shapes (n_in %d, in0 %d, out %d, ws %zu)\n", n_in, n_in > 0 ? in_sizes[0] : -1, out_size, ws_size); grid = -1; return; }
        int dev = 0, cus = 0, per_cu = 0;
        if (hipGetDevice(&dev) != hipSuccess || hipDeviceGetAttribute(&cus, hipDeviceAttributeMultiprocessorCount, dev) != hipSuccess) { grid = -1; return; }
        if (hipFuncSetAttribute((const void*)mega_fwd, hipFuncAttributeMaxDynamicSharedMemorySize, LDS_BYTES) != hipSuccess) { fprintf(stderr, "kernel_launch: hipFuncSetAttribute failed\n"); grid = -1; return; }
        if (hipOccupancyMaxActiveBlocksPerMultiprocessor(&per_cu, (const void*)mega_fwd, NWAVES * 64, LDS_BYTES) != hipSuccess || per_cu < 1) { fprintf(stderr, "kernel_launch: occupancy query says %d\n", per_cu); per_cu = 1; }
        (void)hipGetLastError();
        grid = cus * per_cu;
    }
    if (grid < 0) return;
    (void)hipMemsetAsync((char*)d_ws + WS_CTL, 0, CTL_ZERO_BYTES, stream);
    Args a{};
    a.x = (const float*)d_in[0]; a.ln_g = (const float*)d_in[1]; a.ln_b = (const float*)d_in[2]; a.w_gate = (const float*)d_in[3]; a.w_up = (const float*)d_in[4];
    a.w_down = (const float*)d_in[5]; a.w_in = (const float*)d_in[6]; a.b_gate = (const float*)d_in[7]; a.dlam = (const float*)d_in[8]; a.subg = (const float*)d_in[9];
    a.w_brm = (const float*)d_in[10]; a.w_brd = (const float*)d_in[11]; a.w_brs = (const float*)d_in[12]; a.w_out = (const float*)d_in[13];
    a.out = (float*)d_out; a.ws = (unsigned char*)d_ws;
    void* args[] = {&a};
    hipError_t e = hipLaunchCooperativeKernel((const void*)mega_fwd, dim3(grid), dim3(NWAVES * 64), args, LDS_BYTES, stream);
    if (e != hipSuccess) fprintf(stderr, "kernel_launch: cooperative launch failed: %s (grid %d)\n", hipGetErrorString(e), grid);
}
```

```cpp
#include <hip/hip_runtime.h>
#include <hip/hip_cooperative_groups.h>
#include <cstdio>
#include <cstdint>
#include <cmath>
namespace cg = cooperative_groups;
namespace pg8 {
#define PG8_LAS __attribute__((address_space(3)))
typedef unsigned short bf16_t;
typedef short bf16x8 __attribute__((ext_vector_type(8)));
typedef float f32x4 __attribute__((ext_vector_type(4)));
typedef unsigned u32x4 __attribute__((ext_vector_type(4)));
constexpr int BM = 256, BK = 64, HALF = 128, HTB = HALF * BK * 2  , STAGE_BYTES = 8 * HTB, NXCD = 8, WGM = 8;

__host__ __device__ __forceinline__ int lds_byte(int r, int c) { const int st = (r >> 4) * 2 + (c >> 5), rr = r & 15, cc = c & 31, ob = rr * 64 + cc * 2; return st * 1024 + (ob ^ (((ob >> 9) & 1) << 5)); }
__host__ __device__ __forceinline__ void stage_rc(int b, int& R, int& C) { const int st = b / 1024, sb = b % 1024, swz = sb ^ (((sb >> 9) & 1) << 5); R = (st >> 1) * 16 + swz / 64; C = (st & 1) * 32 + (swz % 64) / 2; }
__host__ __device__ __forceinline__ int perm32(int rho) { const int n = rho >> 4, i = rho & 15; return 8 * (i >> 2) + 4 * n + (i & 3); }

struct Unit { int pm, pn, aoff; };
struct Gemm { const bf16_t* A; const bf16_t* Bt; int M, N, K, lda, ldb; };

struct StaticOrder {
    int nM, nN, nwg, G, c;
    __host__ __device__ void init(int M, int N, int G_, int c_) { nM = M / BM; nN = N / BM; nwg = nM * nN; G = G_; c = c_; }
    __host__ __device__ bool next(int i, Unit& u) const {
        const long L = (long)i * G + c; if (L >= nwg) return false;
        int wgid = (int)L; { const int q = nwg / NXCD, r = nwg % NXCD, xcd = wgid % NXCD, off = wgid / NXCD; wgid = (xcd < r ? xcd * (q + 1) : r * (q + 1) + (xcd - r) * q) + off; }
        const int nig = WGM * nN, gid = wgid / nig, fm = gid * WGM, gsz = (nM - fm) < WGM ? (nM - fm) : WGM;
        u.pm = fm + ((wgid % nig) % gsz); u.pn = (wgid % nig) / gsz; u.aoff = 0; return true;
    }
    __device__ __forceinline__ void a_ready(const Unit&) const {}
    __device__ __forceinline__ void done(const Unit&) const {}
};

typedef float f32x2c_t __attribute__((ext_vector_type(2))); typedef __bf16 bf16x2c_t __attribute__((ext_vector_type(2)));
__device__ __forceinline__ unsigned cvt_pk_bf16(float lo, float hi) { f32x2c_t v = {lo, hi}; bf16x2c_t b = __builtin_convertvector(v, bf16x2c_t); return __builtin_bit_cast(unsigned, b); }
typedef float f32x2 __attribute__((ext_vector_type(2)));
__device__ __forceinline__ float bf2f(unsigned short v) { return __uint_as_float(((unsigned)v) << 16); }
__device__ __forceinline__ float bflo(unsigned v) { return __uint_as_float(v << 16); }
__device__ __forceinline__ float bfhi(unsigned v) { return __uint_as_float(v & 0xffff0000u); }
__device__ __forceinline__ float fast_sigmoid(float v) { return __builtin_amdgcn_rcpf(1.0f + __builtin_amdgcn_exp2f(-1.4426950408889634f * v)); }

struct EpiSwiGLU {
    static constexpr bool PERM = true, AFTER_DRAIN = false;
    bf16_t* H; int ldh;
    __device__ __forceinline__ void operator()(const f32x4 (&acc)[2][2][4][2], const Unit& u, int wr, int wc, int fr, int fq) const {
        const int row0 = u.pm * BM + wr * 64 + fr, col0 = u.pn * HALF + wc * 32 + 8 * fq;
#pragma unroll
        for (int ai = 0; ai < 2; ++ai)
#pragma unroll
            for (int m = 0; m < 4; ++m) {
                bf16_t* rowp = H + (size_t)(row0 + ai * HALF + m * 16) * ldh + col0;
                float h[8];
#pragma unroll
                for (int n = 0; n < 2; ++n)
#pragma unroll
                    for (int i = 0; i < 4; ++i) { const float g = acc[ai][0][m][n][i], up = acc[ai][1][m][n][i]; h[4 * n + i] = g * fast_sigmoid(g) * up; }
                u32x4 w; w.x = cvt_pk_bf16(h[0], h[1]); w.y = cvt_pk_bf16(h[2], h[3]); w.z = cvt_pk_bf16(h[4], h[5]); w.w = cvt_pk_bf16(h[6], h[7]);
                *(u32x4*)rowp = w;
            }
    }
};
struct EpiResid {
    static constexpr bool PERM = false, AFTER_DRAIN = false;
    const float* src; float* out; int ldc; float a, bsc;
    __device__ __forceinline__ void operator()(const f32x4 (&acc)[2][2][4][2], const Unit& u, int wr, int wc, int fr, int fq) const {
        const int row0 = u.pm * BM + wr * 64 + fr, col0 = u.pn * BM + wc * 32 + 4 * fq;
#pragma unroll
        for (int ai = 0; ai < 2; ++ai)
#pragma unroll
            for (int m = 0; m < 4; ++m) {
                const size_t off = (size_t)(row0 + ai * HALF + m * 16) * ldc + col0;
#pragma unroll
                for (int bj = 0; bj < 2; ++bj)
#pragma unroll
                    for (int n = 0; n < 2; ++n) { const f32x4 s = *(const f32x4*)(src + off + bj * HALF + n * 16); *(f32x4*)(out + off + bj * HALF + n * 16) = s * a + acc[ai][bj][m][n] * bsc; }
                if (m & 1) asm volatile("" ::: "memory");
            }
    }
};
struct EpiQKV {
    static constexpr bool PERM = true, AFTER_DRAIN = false;
    bf16_t* QK; bf16_t* VT;
    __device__ __forceinline__ void operator()(const f32x4 (&acc)[2][2][4][2], const Unit& u, int wr, int wc, int fr, int fq) const {
        const int row0 = u.pm * BM + wr * 64 + fr;
        if (u.pn < 9) {
            const int col0 = u.pn * BM + wc * 32 + 8 * fq;
#pragma unroll
            for (int ai = 0; ai < 2; ++ai)
#pragma unroll
                for (int m = 0; m < 4; ++m) { bf16_t* rowp = QK + (size_t)(row0 + ai * HALF + m * 16) * 2304 + col0;
#pragma unroll
                    for (int bj = 0; bj < 2; ++bj) { const f32x4 v0 = acc[ai][bj][m][0], v1 = acc[ai][bj][m][1];
                        u32x4 w; w.x = cvt_pk_bf16(v0[0], v0[1]); w.y = cvt_pk_bf16(v0[2], v0[3]); w.z = cvt_pk_bf16(v1[0], v1[1]); w.w = cvt_pk_bf16(v1[2], v1[3]);
                        *(u32x4*)(rowp + bj * HALF) = w; } }
        } else {
            const int bb = (u.pm * BM) >> 13;
            const int s0 = ((u.pm * BM) & 8191) + wr * 64 + fr;
            const int dd = 32 * (wc & 1) + 8 * fq;
#pragma unroll
            for (int bj = 0; bj < 2; ++bj) {
                const int gh = 4 * (u.pn - 9) + 2 * bj + (wc >> 1);
                if (gh < 18) {
                    const int ty = gh / 6, hh = gh - 6 * ty;
                    bf16_t* base = VT + ((size_t)(((ty * 4 + bb) * 6 + hh) * 64 + dd)) * 8192 + s0;
#pragma unroll
                    for (int ai = 0; ai < 2; ++ai)
#pragma unroll
                        for (int m = 0; m < 4; ++m)
#pragma unroll
                            for (int n = 0; n < 2; ++n) { const f32x4 v = acc[ai][bj][m][n]; const unsigned w0 = cvt_pk_bf16(v[0], v[1]), w1 = cvt_pk_bf16(v[2], v[3]);
                                bf16_t* pp = base + (size_t)(4 * n) * 8192 + ai * HALF + m * 16;
                                pp[0] = (bf16_t)(w0 & 0xffffu); pp[8192] = (bf16_t)(w0 >> 16); pp[2 * 8192] = (bf16_t)(w1 & 0xffffu); pp[3 * 8192] = (bf16_t)(w1 >> 16); }
                }
            }
        }
    }
};
struct EpiGate {
    static constexpr bool PERM = true, AFTER_DRAIN = false;
    bf16_t* G; const float* bias;
    __device__ __forceinline__ void operator()(const f32x4 (&acc)[2][2][4][2], const Unit& u, int wr, int wc, int fr, int fq) const {
        const int row0 = u.pm * BM + wr * 64 + fr, col0 = u.pn * BM + wc * 32 + 8 * fq;
        f32x4 bv[2][2];
#pragma unroll
        for (int bj = 0; bj < 2; ++bj)
#pragma unroll
            for (int n = 0; n < 2; ++n) bv[bj][n] = *(const f32x4*)(bias + col0 + bj * HALF + 4 * n);
#pragma unroll
        for (int ai = 0; ai < 2; ++ai)
#pragma unroll
            for (int m = 0; m < 4; ++m) { bf16_t* rowp = G + (size_t)(row0 + ai * HALF + m * 16) * 3072 + col0;
#pragma unroll
                for (int bj = 0; bj < 2; ++bj) { const f32x4 v0 = acc[ai][bj][m][0] + bv[bj][0], v1 = acc[ai][bj][m][1] + bv[bj][1];
                    u32x4 w; w.x = cvt_pk_bf16(fast_sigmoid(v0[0]), fast_sigmoid(v0[1])); w.y = cvt_pk_bf16(fast_sigmoid(v0[2]), fast_sigmoid(v0[3]));
                    w.z = cvt_pk_bf16(fast_sigmoid(v1[0]), fast_sigmoid(v1[1])); w.w = cvt_pk_bf16(fast_sigmoid(v1[2]), fast_sigmoid(v1[3]));
                    *(u32x4*)(rowp + bj * HALF) = w; } }
    }
};
struct EpiBranch {
    static constexpr bool PERM = true, AFTER_DRAIN = false;
    bf16_t* Mg; const bf16_t* G;
    __device__ __forceinline__ void operator()(const f32x4 (&acc)[2][2][4][2], const Unit& u, int wr, int wc, int fr, int fq) const {
        const int br = u.pn >> 2, pq = u.pn & 3;
        const int row0 = u.pm * BM + wr * 64 + fr, gcol0 = u.pn * BM + wc * 32 + 8 * fq, mcol0 = pq * BM + wc * 32 + 8 * fq;
#pragma unroll
        for (int ai = 0; ai < 2; ++ai)
#pragma unroll
            for (int m = 0; m < 4; ++m) { const size_t r = (size_t)(row0 + ai * HALF + m * 16);
#pragma unroll
                for (int bj = 0; bj < 2; ++bj) {
                    const u32x4 gv = *(const u32x4*)(G + r * 3072 + gcol0 + bj * HALF);
                    bf16_t* mp = Mg + r * 1024 + mcol0 + bj * HALF;
                    const f32x4 v0 = acc[ai][bj][m][0], v1 = acc[ai][bj][m][1];
                    float o[8] = { bflo(gv.x) * v0[0], bfhi(gv.x) * v0[1], bflo(gv.y) * v0[2], bfhi(gv.y) * v0[3], bflo(gv.z) * v1[0], bfhi(gv.z) * v1[1], bflo(gv.w) * v1[2], bfhi(gv.w) * v1[3] };
                    if (br > 0) { const u32x4 ov = *(const u32x4*)mp;
                        o[0] += bflo(ov.x); o[1] += bfhi(ov.x); o[2] += bflo(ov.y); o[3] += bfhi(ov.y); o[4] += bflo(ov.z); o[5] += bfhi(ov.z); o[6] += bflo(ov.w); o[7] += bfhi(ov.w); }
                    u32x4 w; w.x = cvt_pk_bf16(o[0], o[1]); w.y = cvt_pk_bf16(o[2], o[3]); w.z = cvt_pk_bf16(o[4], o[5]); w.w = cvt_pk_bf16(o[6], o[7]);
                    *(u32x4*)mp = w; }
                asm volatile("" ::: "memory"); }
    }
};
struct BranchOrder {
    int G, c;
    __device__ bool next(int i, Unit& u) const {
        const int ti = (i / 3) * G + c, br = i - 3 * (i / 3);
        if (ti >= 512) return false;
        u.pm = ti >> 2; u.pn = br * 4 + (ti & 3); u.aoff = br * 384 * 2; return true;
    }
    __device__ __forceinline__ void a_ready(const Unit&) const {}
    __device__ __forceinline__ void done(const Unit&) const {}
};

template <class Epi, class Sched, bool ALIGN_EPI = false, bool SP2 = false>
__device__ __forceinline__ void gemm_phase(PG8_LAS unsigned char* lds, const Gemm g, const Sched& S, const Epi& E, const int tid_in) {
    int tid = tid_in; asm volatile("" : "+v"(tid));
    const int wid = __builtin_amdgcn_readfirstlane(tid >> 6), lane = tid & 63, wr = wid >> 2, wc = wid & 3, fr = lane & 15, fq = lane >> 4;
    const int K = g.K, nt = K / BK;
    unsigned voffA[2], voffB[2];
#pragma unroll
    for (int i = 0; i < 2; ++i) { int R, C; stage_rc(tid * 16 + i * 8192, R, C); const int Rb = Epi::PERM ? ((R & ~31) + perm32(R & 31)) : R;
        voffA[i] = (unsigned)(R * g.lda + C) * 2u; voffB[i] = (unsigned)(Rb * g.ldb + C) * 2u; }
    const size_t kstep = (size_t)(BK * 2);
    const size_t hstepA = (size_t)HALF * g.lda * 2, hstepB = (size_t)HALF * g.ldb * 2;
    const size_t tstepA = 2 * hstepA, tstepB = 2 * hstepB;
    const unsigned ldsw = (unsigned)wid * 1024u;
    const int aoff = lds_byte(wr * 64 + fr, fq * 8), boff = lds_byte(wc * 32 + fr, fq * 8);
#define PG8_SA(b, h) (((b) * 2 + (h)) * HTB)
#define PG8_SB(b, h) ((4 + (b) * 2 + (h)) * HTB)
#define PG8_STAGE(bufoff, gbase, voff) do { _Pragma("unroll") for (int _i = 0; _i < 2; ++_i) \
        __builtin_amdgcn_global_load_lds((const unsigned*)((const char*)(gbase) + (voff)[_i]), (PG8_LAS unsigned*)(lds + (bufoff) + ldsw + _i * 8192), 16, 0, 0); } while (0)
#define PG8_LDA(dst, b, h) do { _Pragma("unroll") for (int m = 0; m < 4; ++m) _Pragma("unroll") for (int k = 0; k < 2; ++k) dst[m][k] = *(const PG8_LAS bf16x8*)(lds + PG8_SA(b, h) + aoff + m * 2048 + k * 1024); } while (0)
#define PG8_LDB(dst, b, h) do { _Pragma("unroll") for (int n = 0; n < 2; ++n) _Pragma("unroll") for (int k = 0; k < 2; ++k) dst[n][k] = *(const PG8_LAS bf16x8*)(lds + PG8_SB(b, h) + boff + n * 2048 + k * 1024); } while (0)
#define PG8_MMA(ai, bj, At, Bt) do { __builtin_amdgcn_s_setprio(1); _Pragma("unroll") for (int m = 0; m < 4; ++m) _Pragma("unroll") for (int n = 0; n < 2; ++n) _Pragma("unroll") for (int k = 0; k < 2; ++k) \
        acc[ai][bj][m][n] = __builtin_amdgcn_mfma_f32_16x16x32_bf16(Bt[n][k], At[m][k], acc[ai][bj][m][n], 0, 0, 0); __builtin_amdgcn_s_setprio(0); } while (0)
#define PG8_WAIT_V(n) asm volatile("s_waitcnt vmcnt(" #n ")" ::: "memory")
#define PG8_WAIT_L(n) asm volatile("s_waitcnt lgkmcnt(" #n ")" ::: "memory")
#define PG8_BAR __builtin_amdgcn_s_barrier()
#define PG8_SCHED __builtin_amdgcn_sched_barrier(0)
    Unit cur, nxt; int ui = 0;
    if (!S.next(0, cur)) return;
    f32x4 acc[2][2][4][2];
#pragma unroll
    for (int a = 0; a < 2; ++a)
#pragma unroll
        for (int b = 0; b < 2; ++b)
#pragma unroll
            for (int m = 0; m < 4; ++m)
#pragma unroll
                for (int n = 0; n < 2; ++n) acc[a][b][m][n] = (f32x4){0.f, 0.f, 0.f, 0.f};
    bf16x8 At[4][2], B0[2][2], B1[2][2];
    const char* cA = (const char*)g.A + (size_t)cur.pm * tstepA + cur.aoff; const char* cB = (const char*)g.Bt + (size_t)cur.pn * tstepB;
    S.a_ready(cur);
    if constexpr (SP2) {
        PG8_STAGE(PG8_SB(0, 0), cB, voffB); PG8_STAGE(PG8_SB(0, 1), cB + hstepB, voffB); PG8_STAGE(PG8_SA(0, 0), cA, voffA); PG8_STAGE(PG8_SA(0, 1), cA + hstepA, voffA);
        if (wr == 1) PG8_BAR;
        PG8_WAIT_V(2); PG8_BAR;
        PG8_STAGE(PG8_SB(1, 0), cB + kstep, voffB); PG8_STAGE(PG8_SA(1, 0), cA + kstep, voffA); PG8_STAGE(PG8_SB(1, 1), cB + hstepB + kstep, voffB);
        PG8_WAIT_V(6); PG8_BAR;
    } else {
        PG8_STAGE(PG8_SB(0, 0), cB, voffB); PG8_STAGE(PG8_SA(0, 0), cA, voffA); PG8_STAGE(PG8_SB(0, 1), cB + hstepB, voffB); PG8_STAGE(PG8_SA(0, 1), cA + hstepA, voffA);
        if (wr == 1) PG8_BAR;
        PG8_WAIT_V(4); PG8_BAR;
        PG8_STAGE(PG8_SB(1, 0), cB + kstep, voffB); PG8_STAGE(PG8_SA(1, 0), cA + kstep, voffA); PG8_STAGE(PG8_SB(1, 1), cB + hstepB + kstep, voffB);
        PG8_WAIT_V(6); PG8_BAR;
    }
    for (;;) {
        const bool has_next = S.next(ui + 1, nxt);
        const char* nA = has_next ? (const char*)g.A + (size_t)nxt.pm * tstepA + nxt.aoff : cA; const char* nB = has_next ? (const char*)g.Bt + (size_t)nxt.pn * tstepB : cB;
        for (int t = 0; t < nt; t += 2) {
            const bool last = (t == nt - 2);
            const char* a1 = cA + (size_t)(t + 1) * kstep;
            const char* a2 = last ? nA : cA + (size_t)(t + 2) * kstep; const char* b2 = last ? nB : cB + (size_t)(t + 2) * kstep;
            const char* a3 = a2 + kstep; const char* b3 = b2 + kstep;
            if (last && has_next) S.a_ready(nxt);
            if constexpr (SP2) {
            PG8_LDB(B0, 0, 0); PG8_LDB(B1, 0, 1); PG8_SCHED; PG8_LDA(At, 0, 0); PG8_STAGE(PG8_SA(1, 1), a1 + hstepA, voffA);
            PG8_WAIT_V(8); PG8_WAIT_L(0); PG8_BAR; PG8_MMA(0, 0, At, B0); PG8_MMA(0, 1, At, B1); PG8_BAR; PG8_SCHED;
            PG8_LDA(At, 0, 1); PG8_STAGE(PG8_SB(0, 0), b2, voffB); PG8_STAGE(PG8_SB(0, 1), b2 + hstepB, voffB); PG8_STAGE(PG8_SA(0, 0), a2, voffA);
            PG8_WAIT_V(8); PG8_WAIT_L(0); PG8_BAR; PG8_MMA(1, 0, At, B0); PG8_MMA(1, 1, At, B1); PG8_BAR; PG8_SCHED;
            PG8_LDB(B0, 1, 0); PG8_LDB(B1, 1, 1); PG8_SCHED; PG8_LDA(At, 1, 0); PG8_STAGE(PG8_SA(0, 1), a2 + hstepA, voffA);
            PG8_WAIT_V(8); PG8_WAIT_L(0); PG8_BAR; PG8_MMA(0, 0, At, B0); PG8_MMA(0, 1, At, B1); PG8_BAR; PG8_SCHED;
            PG8_LDA(At, 1, 1); PG8_STAGE(PG8_SB(1, 0), b3, voffB); PG8_STAGE(PG8_SB(1, 1), b3 + hstepB, voffB); PG8_STAGE(PG8_SA(1, 0), a3, voffA);
            PG8_WAIT_V(8); PG8_WAIT_L(0); PG8_BAR; PG8_MMA(1, 0, At, B0); PG8_MMA(1, 1, At, B1); PG8_BAR; PG8_SCHED;
            } else {
            PG8_LDB(B0, 0, 0); PG8_SCHED; PG8_LDA(At, 0, 0); PG8_STAGE(PG8_SA(1, 1), a1 + hstepA, voffA);
            PG8_WAIT_L(8); PG8_BAR; PG8_WAIT_L(0); PG8_MMA(0, 0, At, B0); PG8_BAR; PG8_SCHED;
            PG8_LDB(B1, 0, 1); PG8_STAGE(PG8_SB(0, 0), b2, voffB);
            PG8_BAR; PG8_WAIT_L(0); PG8_MMA(0, 1, At, B1); PG8_BAR;
            PG8_LDA(At, 0, 1); PG8_STAGE(PG8_SA(0, 0), a2, voffA);
            PG8_BAR; PG8_WAIT_L(0); PG8_MMA(1, 0, At, B0); PG8_BAR; PG8_SCHED;
            PG8_STAGE(PG8_SB(0, 1), b2 + hstepB, voffB);
            PG8_WAIT_V(6); PG8_BAR; PG8_MMA(1, 1, At, B1); PG8_BAR;
            PG8_LDB(B0, 1, 0); PG8_SCHED; PG8_LDA(At, 1, 0); PG8_STAGE(PG8_SA(0, 1), a2 + hstepA, voffA);
            PG8_WAIT_L(8); PG8_BAR; PG8_WAIT_L(0); PG8_MMA(0, 0, At, B0); PG8_BAR; PG8_SCHED;
            PG8_LDB(B1, 1, 1); PG8_STAGE(PG8_SB(1, 0), b3, voffB);
            PG8_BAR; PG8_WAIT_L(0); PG8_MMA(0, 1, At, B1); PG8_BAR;
            PG8_LDA(At, 1, 1); PG8_STAGE(PG8_SA(1, 0), a3, voffA);
            PG8_BAR; PG8_WAIT_L(0); PG8_MMA(1, 0, At, B0); PG8_BAR; PG8_SCHED;
            PG8_STAGE(PG8_SB(1, 1), b3 + hstepB, voffB);
            PG8_WAIT_V(6); PG8_BAR; PG8_MMA(1, 1, At, B1); PG8_BAR;
            }
        }
        if constexpr (ALIGN_EPI) { if (wr == 0) PG8_BAR; }
        if constexpr (!Epi::AFTER_DRAIN) { int ln_; asm volatile("v_mbcnt_lo_u32_b32 %0, -1, 0\n\tv_mbcnt_hi_u32_b32 %0, -1, %0" : "=v"(ln_)); const int fr_ = ln_ & 15, fq_ = ln_ >> 4; E(acc, cur, wr, wc, fr_, fq_); S.done(cur); }
        if (!has_next) break;
#pragma unroll
        for (int a = 0; a < 2; ++a)
#pragma unroll
            for (int b = 0; b < 2; ++b)
#pragma unroll
                for (int m = 0; m < 4; ++m)
#pragma unroll
                    for (int n = 0; n < 2; ++n) acc[a][b][m][n] = (f32x4){0.f, 0.f, 0.f, 0.f};
        cur = nxt; cA = nA; cB = nB; ++ui;
        if constexpr (ALIGN_EPI) { if (wr == 1) PG8_BAR; }
    }
    PG8_WAIT_V(0);
    if constexpr (!ALIGN_EPI) { if (wr == 0) PG8_BAR; }
    PG8_BAR;
    if constexpr (Epi::AFTER_DRAIN) { E.fused(acc, cur, wr, wc, fr, fq, lds, wid, lane); S.done(cur); }
#undef PG8_SA
#undef PG8_SB
#undef PG8_STAGE
#undef PG8_LDA
#undef PG8_LDB
#undef PG8_MMA
#undef PG8_WAIT_V
#undef PG8_WAIT_L
#undef PG8_BAR
#undef PG8_SCHED
}
}
using pg8::bf16_t; using pg8::bf16x8; using pg8::f32x4; using pg8::u32x4;
typedef float f32x16 __attribute__((ext_vector_type(16)));
typedef unsigned u32x2 __attribute__((ext_vector_type(2)));
#define LAS __attribute__((address_space(3)))
constexpr int NWAVES = 8;
constexpr int DM = 1024, NBATCH = 4, SEQ = 8192, DEPTH = 2, DFF = 2816, NHEADS = 6;
constexpr int M = NBATCH * SEQ;
constexpr int NIN = 6528, NQKVP = 3584, NGATE = 3072, QKP = 2304, OP = 1152;
constexpr float LN_EPS = 1e-5f, SUBLN_EPS = 1e-5f;
constexpr size_t MiB = 1u << 20;
constexpr size_t WS_CTL = 0, CTL_ZERO_BYTES = 32768;
constexpr int CW_BAR = 2048;
constexpr size_t WS_KMEAN = 256 * 1024;
constexpr size_t WS_WGU = 1 * MiB;
constexpr size_t WS_WD = WS_WGU + 2 * (size_t)5632 * 1024 * 2;
constexpr size_t WS_WIN = WS_WD + 2 * (size_t)1024 * 2816 * 2;
constexpr size_t WS_WBR = WS_WIN + (size_t)6656 * 1024 * 2;
constexpr size_t WS_WOUT = WS_WBR + (size_t)3072 * 384 * 2;
constexpr size_t WS_WEND = WS_WOUT + (size_t)1024 * 1024 * 2;
constexpr size_t WS_XB = 52 * MiB;
constexpr size_t WS_QK = 116 * MiB;
constexpr size_t WS_VT = 260 * MiB;
constexpr size_t WS_O = 332 * MiB;
constexpr size_t WS_MG = 404 * MiB;
constexpr size_t WS_G = 116 * MiB;
constexpr size_t WS_H = 116 * MiB;
constexpr size_t WS_END = 468 * MiB;
static_assert(WS_WEND <= WS_XB && WS_XB + (size_t)M * DM * 2 <= WS_QK && WS_QK + (size_t)M * QKP * 2 <= WS_VT && WS_VT + (size_t)72 * MiB <= WS_O && WS_O + (size_t)M * OP * 2 <= WS_MG && WS_MG + (size_t)M * DM * 2 <= WS_END, "ws map");
static_assert(WS_G + (size_t)M * NGATE * 2 <= WS_O && WS_H + (size_t)M * DFF * 2 <= WS_O, "overlay");
constexpr int LDS_BYTES = pg8::STAGE_BYTES + 256;

struct Args {
    const float *x, *ln_g, *ln_b, *w_gate, *w_up, *w_down, *w_in, *b_gate, *dlam, *subg, *w_brm, *w_brd, *w_brs, *w_out;
    float* out; unsigned char* ws;
};

__device__ __forceinline__ unsigned f2bf(float f) { unsigned u = __builtin_bit_cast(unsigned, f); return (u + 0x7fffu + ((u >> 16) & 1u)) >> 16; }
__device__ __forceinline__ unsigned pk2(float lo, float hi) { return f2bf(lo) | (f2bf(hi) << 16); }
__device__ __forceinline__ float shx(float v, int mask, int lane) { return __int_as_float(__builtin_amdgcn_ds_bpermute((lane ^ mask) << 2, __float_as_int(v))); }
__device__ __forceinline__ float wave_sum(float v, int lane) {
#pragma unroll
    for (int o = 1; o < 64; o <<= 1) v += shx(v, o, lane);
    return v;
}
__device__ __forceinline__ void p0_item(const float* W, int K, int N, bf16_t* WT, int k0, int n0, int drow, LAS float* scr, int lane) {
#pragma unroll 8
    for (int i = 0; i < 32; ++i) { const int kk = 2 * i + (lane >> 5); scr[kk * 33 + (lane & 31)] = W[(size_t)(k0 + kk) * N + n0 + (lane & 31)]; }
    asm volatile("s_waitcnt lgkmcnt(0)" ::: "memory");
    const int c = lane & 7;
#pragma unroll
    for (int j = 0; j < 4; ++j) { const int n = (lane >> 3) + 8 * j; const LAS float* s = scr + (8 * c) * 33 + n;
        u32x4 o; o.x = pk2(s[0 * 33], s[1 * 33]); o.y = pk2(s[2 * 33], s[3 * 33]); o.z = pk2(s[4 * 33], s[5 * 33]); o.w = pk2(s[6 * 33], s[7 * 33]);
        *(u32x4*)(WT + (size_t)(drow + n) * K + k0 + 8 * c) = o; }
    asm volatile("s_waitcnt lgkmcnt(0)" ::: "memory");
}
typedef const __attribute__((address_space(4))) Args* ArgsP;
__device__ __forceinline__ void p0_convert(ArgsP a, unsigned char* ws, int l, LAS unsigned char* lds, int gw, int NGW, int wave, int lane) {
    LAS float* scr = (LAS float*)(lds + wave * 16384);
    constexpr int I_G = 2 * 16 * 88, I_D = 2 * 44 * 32, I_IN = 16 * 204, I_BR = 3 * 6 * 32, I_O = 16 * 32;
    constexpr int NITEMS = 2 * I_G + I_D + I_IN + I_BR + I_O;
    for (int it = gw; it < NITEMS; it += NGW) {
        int r = it;
        if (r < 2 * I_G) {
            const int up = r >= I_G; if (up) r -= I_G;
            const int f = r / (16 * 88); r -= f * (16 * 88);
            const int kb = r / 88, nb = r - kb * 88, n0 = 32 * nb;
            const float* W = (up ? a->w_up : a->w_gate) + (size_t)(l * 2 + f) * DM * DFF;
            bf16_t* WT = (bf16_t*)(ws + WS_WGU) + (size_t)f * 5632 * 1024;
            p0_item(W, DM, DFF, WT, 64 * kb, n0, 256 * (n0 >> 7) + 128 * up + (n0 & 127), scr, lane);
            continue;
        }
        r -= 2 * I_G;
        if (r < I_D) {
            const int f = r / (44 * 32); r -= f * (44 * 32);
            const int kb = r / 32, nb = r - kb * 32;
            p0_item(a->w_down + (size_t)(l * 2 + f) * DFF * DM, DFF, DM, (bf16_t*)(ws + WS_WD) + (size_t)f * 1024 * 2816, 64 * kb, 32 * nb, 32 * nb, scr, lane);
            continue;
        }
        r -= I_D;
        if (r < I_IN) {
            const int kb = r / 204, nb = r - kb * 204, n0 = 32 * nb;
            int drow;
            if (n0 < 3456) { const int seg = n0 / 384, rem = n0 - seg * 384, ty = seg / 3, qkv = seg - 3 * ty; drow = (qkv < 2 ? ty * 768 + qkv * 384 : 2304 + ty * 384) + rem; }
            else drow = n0 + 128;
            p0_item(a->w_in + (size_t)l * DM * NIN, DM, NIN, (bf16_t*)(ws + WS_WIN), 64 * kb, n0, drow, scr, lane);
            continue;
        }
        r -= I_IN;
        if (r < I_BR) {
            const int br = r / (6 * 32); r -= br * (6 * 32);
            const int kb = r / 32, nb = r - kb * 32;
            const float* W = (br == 0 ? a->w_brm : (br == 1 ? a->w_brd : a->w_brs)) + (size_t)l * 384 * DM;
            p0_item(W, 384, DM, (bf16_t*)(ws + WS_WBR), 64 * kb, 32 * nb, br * 1024 + 32 * nb, scr, lane);
            continue;
        }
        r -= I_BR;
        { const int kb = r / 32, nb = r - kb * 32;
          p0_item(a->w_out + (size_t)l * DM * DM, DM, DM, (bf16_t*)(ws + WS_WOUT), 64 * kb, 32 * nb, 32 * nb, scr, lane); }
    }
    if (l == 0) {
        bf16_t* XB = (bf16_t*)(ws + WS_XB);
        for (int m = gw; m < M; m += NGW) {
            const f32x4* xr = (const f32x4*)(a->x + (size_t)m * DM) + lane; u32x2* o8 = (u32x2*)(XB + (size_t)m * DM) + lane;
#pragma unroll
            for (int j = 0; j < 4; ++j) { const f32x4 v = xr[64 * j]; u32x2 w; w.x = pk2(v.x, v.y); w.y = pk2(v.z, v.w); o8[64 * j] = w; }
        }
    }
}
__device__ __forceinline__ void ln_phase(float* out, bf16_t* XB, const float* g, const float* b, int gw, int NGW, int lane) {
    f32x4 gv[4], bv[4];
#pragma unroll
    for (int j = 0; j < 4; ++j) { gv[j] = ((const f32x4*)g)[lane + 64 * j]; bv[j] = ((const f32x4*)b)[lane + 64 * j]; }
    for (int m = gw; m < M; m += NGW) {
        f32x4* xr = (f32x4*)(out + (size_t)m * DM) + lane; u32x2* o8 = (u32x2*)(XB + (size_t)m * DM) + lane;
        f32x4 v[4]; float s = 0.f;
#pragma unroll
        for (int j = 0; j < 4; ++j) { v[j] = xr[64 * j]; s += (v[j].x + v[j].y) + (v[j].z + v[j].w); }
        const float mean = wave_sum(s, lane) * (1.f / DM); float s2 = 0.f;
#pragma unroll
        for (int j = 0; j < 4; ++j) { v[j] = v[j] - mean; s2 += (v[j].x * v[j].x + v[j].y * v[j].y) + (v[j].z * v[j].z + v[j].w * v[j].w); }
        const float rstd = 1.f / sqrtf(wave_sum(s2, lane) * (1.f / DM) + LN_EPS);
#pragma unroll
        for (int j = 0; j < 4; ++j) { const f32x4 y = v[j] * rstd * gv[j] + bv[j]; xr[64 * j] = y; u32x2 w; w.x = pk2(y.x, y.y); w.y = pk2(y.z, y.w); o8[64 * j] = w; }
    }
}
__device__ __forceinline__ void kmean_phase(const bf16_t* QK, float* kmean, int gw, int NGW, int lane) {
    for (int it = gw; it < NBATCH * NHEADS * 32; it += NGW) {
        const int n = it & 31, bh = it >> 5, b = bh / NHEADS, h = bh - b * NHEADS;
        const bf16_t* kp = QK + ((size_t)b * SEQ + (size_t)n * 256) * QKP + 384 + h * 64 + lane;
        float s = 0.f;
#pragma unroll 8
        for (int i = 0; i < 256; ++i) s += pg8::bf2f(kp[(size_t)i * QKP]);
        kmean[(size_t)it * 64 + lane] = s * (1.f / 256.f);
    }
}
#define MFMA32(a, b, c) __builtin_amdgcn_mfma_f32_32x32x16_bf16((a), (b), (c), 0, 0, 0)
using pg8::cvt_pk_bf16;
__device__ __forceinline__ bf16x8 ld8(const bf16_t* p) { return *(const bf16x8*)p; }
__device__ __forceinline__ int swap23(int i) { return (i & ~12) | ((i & 4) << 1) | ((i & 8) >> 1); }
template <int ST> __device__ __forceinline__ bf16x8 pack8(const f32x16& x) {
    u32x4 p; p.x = cvt_pk_bf16(x[8 * ST + 0], x[8 * ST + 1]); p.y = cvt_pk_bf16(x[8 * ST + 2], x[8 * ST + 3]); p.z = cvt_pk_bf16(x[8 * ST + 4], x[8 * ST + 5]); p.w = cvt_pk_bf16(x[8 * ST + 6], x[8 * ST + 7]);
    return __builtin_bit_cast(bf16x8, p);
}
__device__ __forceinline__ f32x16 zero16() { f32x16 z;
#pragma unroll
    for (int r = 0; r < 16; ++r) z[r] = 0.f;
    return z; }
__device__ __forceinline__ int keyof(int r, int hi) { return 16 * (r >> 3) + 8 * hi + (r & 7); }
struct AttnP { const bf16_t* QK; const bf16_t* VT; bf16_t* O; const float* kmean; const float* dlam; const float* subg; unsigned* ctr; int layer; };

__device__ __forceinline__ void sm_update(f32x16& s, float& m, float& l, f32x16 (&o)[2], int lane) {
    float mt = s[0];
#pragma unroll
    for (int r = 1; r < 16; ++r) mt = fmaxf(mt, s[r]);
    mt = fmaxf(mt, shx(mt, 32, lane));
    const float mn = fmaxf(m, mt);
    const float mref = (mn == -INFINITY) ? 0.f : mn;
    const float corr = __builtin_amdgcn_exp2f(m - mref);
    m = mn;
    float ps = 0.f;
#pragma unroll
    for (int r = 0; r < 16; ++r) { s[r] = __builtin_amdgcn_exp2f(s[r] - mref); ps += s[r]; }
    l = l * corr + ps;
    if (__builtin_amdgcn_ballot_w64(corr != 1.0f) != 0ull) {
#pragma unroll
        for (int r = 0; r < 16; ++r) { o[0][r] *= corr; o[1][r] *= corr; }
    }
}
__device__ __forceinline__ void pv_acc(f32x16 (&o)[2], const bf16x8 (&v)[4], const bf16x8 p0, const bf16x8 p1) {
    o[0] = MFMA32(v[0], p0, o[0]); o[0] = MFMA32(v[1], p1, o[0]);
    o[1] = MFMA32(v[2], p0, o[1]); o[1] = MFMA32(v[3], p1, o[1]);
}
__device__ __forceinline__ void ldv(bf16x8 (&v)[4], const bf16_t* VTb, int kt0, int j, int hi) {
    const bf16_t* vp = VTb + (size_t)j * SEQ + kt0 + hi * 8;
    v[0] = ld8(vp); v[1] = ld8(vp + 16); v[2] = ld8(vp + (size_t)32 * SEQ); v[3] = ld8(vp + (size_t)32 * SEQ + 16);
}
__device__ __forceinline__ void store_o(bf16_t* orow, const f32x16 (&o)[2], int hi) {
#pragma unroll
    for (int db = 0; db < 2; ++db)
#pragma unroll
        for (int g = 0; g < 4; ++g) { u32x2 w; w.x = cvt_pk_bf16(o[db][4 * g], o[db][4 * g + 1]); w.y = cvt_pk_bf16(o[db][4 * g + 2], o[db][4 * g + 3]);
            *(u32x2*)(orow + 32 * db + 8 * g + 4 * hi) = w; }
}

__device__ __forceinline__ void moba_unit(const AttnP& p, int b, int h, int qt, int lane) {
    const int j = lane & 31, hi = lane >> 5, t0 = qt * 32, own = t0 >> 8, t = t0 + j, kr = swap23(j);
    const size_t rowb = (size_t)b * SEQ;
    const bf16_t* Qp = p.QK + (rowb + t) * QKP + h * 64;
    const bf16_t* Kb = p.QK + rowb * QKP + 384 + h * 64 + hi * 8;
    const bf16_t* VTb = p.VT + ((size_t)((0 * 4 + b) * 6 + h) * 64) * SEQ;
    bf16x8 qf[4];
#pragma unroll
    for (int ks = 0; ks < 4; ++ks) qf[ks] = ld8(Qp + ks * 16 + hi * 8);
    float v0 = -INFINITY, v1 = -INFINITY, v2 = -INFINITY; int i0 = -1, i1 = -1, i2 = -1;
    if (own > 0) {
        float qv[32];
#pragma unroll
        for (int c = 0; c < 4; ++c) { const u32x4 w = *(const u32x4*)(Qp + 32 * hi + 8 * c);
            qv[8 * c + 0] = pg8::bflo(w.x); qv[8 * c + 1] = pg8::bfhi(w.x); qv[8 * c + 2] = pg8::bflo(w.y); qv[8 * c + 3] = pg8::bfhi(w.y);
            qv[8 * c + 4] = pg8::bflo(w.z); qv[8 * c + 5] = pg8::bfhi(w.z); qv[8 * c + 6] = pg8::bflo(w.w); qv[8 * c + 7] = pg8::bfhi(w.w); }
        const float* km = p.kmean + ((size_t)(b * NHEADS + h) * 32) * 64 + 32 * hi;
        for (int n = 0; n < own; ++n) {
            float g = 0.f;
#pragma unroll
            for (int c = 0; c < 8; ++c) { const f32x4 kv = *(const f32x4*)(km + n * 64 + 4 * c);
                g += qv[4 * c] * kv.x; g += qv[4 * c + 1] * kv.y; g += qv[4 * c + 2] * kv.z; g += qv[4 * c + 3] * kv.w; }
            g += shx(g, 32, lane);
            if (g > v0) { v2 = v1; i2 = i1; v1 = v0; i1 = i0; v0 = g; i0 = n; }
            else if (g > v1) { v2 = v1; i2 = i1; v1 = g; i1 = n; }
            else if (g > v2) { v2 = g; i2 = n; }
        }
    }
    const float c1 = 0.125f * 1.4426950408889634f;
    const float sl2 = __builtin_amdgcn_exp2f(-8.0f * (float)(2 * h + 1) / 12.0f) * 1.4426950408889634f;
    float m = -INFINITY, l = 0.f; f32x16 o[2]; o[0] = zero16(); o[1] = zero16();
    for (int kt0 = t0; kt0 >= own * 256; kt0 -= 32) {
        const bf16_t* kp = Kb + (size_t)(kt0 + kr) * QKP;
        const bf16x8 k0 = ld8(kp), k1 = ld8(kp + 16), k2 = ld8(kp + 32), k3 = ld8(kp + 48);
        bf16x8 v[4]; ldv(v, VTb, kt0, j, hi);
        f32x16 s = zero16();
        s = MFMA32(k0, qf[0], s); s = MFMA32(k1, qf[1], s); s = MFMA32(k2, qf[2], s); s = MFMA32(k3, qf[3], s);
#pragma unroll
        for (int r = 0; r < 16; ++r) { const int dist = t - (kt0 + keyof(r, hi)); s[r] = dist >= 0 ? s[r] * c1 - sl2 * (float)dist : -INFINITY; }
        sm_update(s, m, l, o, lane);
        pv_acc(o, v, pack8<0>(s), pack8<1>(s));
    }
    for (int n = 0; n < own; ++n) {
        const bool sel = (n == i0) || (n == i1) || (n == i2);
        if (__builtin_amdgcn_ballot_w64(sel) == 0ull) continue;
        for (int kt0 = n * 256; kt0 < n * 256 + 256; kt0 += 32) {
            const bf16_t* kp = Kb + (size_t)(kt0 + kr) * QKP;
            const bf16x8 k0 = ld8(kp), k1 = ld8(kp + 16), k2 = ld8(kp + 32), k3 = ld8(kp + 48);
            bf16x8 v[4]; ldv(v, VTb, kt0, j, hi);
            f32x16 s = zero16();
            s = MFMA32(k0, qf[0], s); s = MFMA32(k1, qf[1], s); s = MFMA32(k2, qf[2], s); s = MFMA32(k3, qf[3], s);
#pragma unroll
            for (int r = 0; r < 16; ++r) { const int dist = t - (kt0 + keyof(r, hi)); s[r] = sel ? s[r] * c1 - sl2 * (float)dist : -INFINITY; }
            sm_update(s, m, l, o, lane);
            pv_acc(o, v, pack8<0>(s), pack8<1>(s));
        }
    }
    l += shx(l, 32, lane);
    const float inv = 1.0f / l;
#pragma unroll
    for (int r = 0; r < 16; ++r) { o[0][r] *= inv; o[1][r] *= inv; }
    store_o(p.O + (rowb + t) * OP + 0 * 384 + h * 64, o, hi);
}

__device__ __forceinline__ void diff_unit(const AttnP& p, int b, int h, int qt, int lane, float lam, float lambda_init) {
    const int j = lane & 31, hi = lane >> 5, t0 = qt * 32, t = t0 + j, kr = swap23(j);
    const size_t rowb = (size_t)b * SEQ;
    const bf16_t* Qp = p.QK + (rowb + t) * QKP + 768 + h * 64 + hi * 8;
    const bf16_t* Kb = p.QK + rowb * QKP + 1152 + h * 64 + hi * 8;
    const bf16_t* VTb = p.VT + ((size_t)((1 * 4 + b) * 6 + h) * 64) * SEQ;
    const bf16x8 qa0 = ld8(Qp), qa1 = ld8(Qp + 16), qb0 = ld8(Qp + 32), qb1 = ld8(Qp + 48);
    const float c1 = 0.17677669529663687f * 1.4426950408889634f;
    const float sl2 = __builtin_amdgcn_exp2f(-8.0f * (float)(2 * h + 2) / 12.0f) * 1.4426950408889634f;
    float m1 = -INFINITY, l1 = 0.f, m2 = -INFINITY, l2 = 0.f;
    f32x16 o1[2], o2[2]; o1[0] = zero16(); o1[1] = zero16(); o2[0] = zero16(); o2[1] = zero16();
    for (int kt0 = t0; kt0 >= 0; kt0 -= 32) {
        const bf16_t* kp = Kb + (size_t)(kt0 + kr) * QKP;
        const bf16x8 ka0 = ld8(kp), ka1 = ld8(kp + 16), kb0 = ld8(kp + 32), kb1 = ld8(kp + 48);
        bf16x8 v[4]; ldv(v, VTb, kt0, j, hi);
        const float dl = (float)(t - kt0 - 8 * hi);
        {
            f32x16 s1 = zero16();
            s1 = MFMA32(ka0, qa0, s1); s1 = MFMA32(ka1, qa1, s1);
#pragma unroll
            for (int r = 0; r < 16; ++r) { const float dd = dl - (float)(16 * (r >> 3) + (r & 7)); s1[r] = (dd >= 0.f) ? s1[r] * c1 - sl2 * dd : -INFINITY; }
            sm_update(s1, m1, l1, o1, lane);
            pv_acc(o1, v, pack8<0>(s1), pack8<1>(s1));
        }
        __builtin_amdgcn_sched_barrier(0);
        {
            f32x16 s2 = zero16();
            s2 = MFMA32(kb0, qb0, s2); s2 = MFMA32(kb1, qb1, s2);
#pragma unroll
            for (int r = 0; r < 16; ++r) { const float dd = dl - (float)(16 * (r >> 3) + (r & 7)); s2[r] = (dd >= 0.f) ? s2[r] * c1 - sl2 * dd : -INFINITY; }
            sm_update(s2, m2, l2, o2, lane);
            pv_acc(o2, v, pack8<0>(s2), pack8<1>(s2));
        }
    }
    l1 += shx(l1, 32, lane); l2 += shx(l2, 32, lane);
    const float i1 = 1.0f / l1, i2 = lam / l2;
    float ss = 0.f;
#pragma unroll
    for (int r = 0; r < 16; ++r) { o1[0][r] = o1[0][r] * i1 - o2[0][r] * i2; o1[1][r] = o1[1][r] * i1 - o2[1][r] * i2; ss += o1[0][r] * o1[0][r] + o1[1][r] * o1[1][r]; }
    ss += shx(ss, 32, lane);
    const float rn = (1.0f / sqrtf(ss * (1.0f / 64.0f) + SUBLN_EPS)) * (1.0f - lambda_init);
#pragma unroll
    for (int db = 0; db < 2; ++db)
#pragma unroll
        for (int g = 0; g < 4; ++g) { const f32x4 gv = *(const f32x4*)(p.subg + 32 * db + 8 * g + 4 * hi);
            o1[db][4 * g] *= rn * gv.x; o1[db][4 * g + 1] *= rn * gv.y; o1[db][4 * g + 2] *= rn * gv.z; o1[db][4 * g + 3] *= rn * gv.w; }
    store_o(p.O + (rowb + t) * OP + 1 * 384 + h * 64, o1, hi);
}

__device__ __forceinline__ void sb_unit(const AttnP& p, int b, int h, int qt, int lane) {
    const int j = lane & 31, hi = lane >> 5, t0 = qt * 32, t = t0 + j, kr = swap23(j);
    const size_t rowb = (size_t)b * SEQ;
    const bf16_t* Qp = p.QK + (rowb + t) * QKP + 1536 + h * 64 + hi * 8;
    const bf16_t* Kb = p.QK + rowb * QKP + 1920 + h * 64 + hi * 8;
    const bf16_t* VTb = p.VT + ((size_t)((2 * 4 + b) * 6 + h) * 64) * SEQ;
    bf16x8 qf[4];
#pragma unroll
    for (int ks = 0; ks < 4; ++ks) qf[ks] = ld8(Qp + ks * 16);
    f32x16 o[2]; o[0] = zero16(); o[1] = zero16();
    float R = 0.f;
    for (int kt0 = t0; kt0 >= 0; kt0 -= 32) {
        const bf16_t* kp = Kb + (size_t)(kt0 + kr) * QKP;
        const bf16x8 k0 = ld8(kp), k1 = ld8(kp + 16), k2 = ld8(kp + 32), k3 = ld8(kp + 48);
        bf16x8 v[4]; ldv(v, VTb, kt0, j, hi);
        f32x16 z = zero16();
        z = MFMA32(k0, qf[0], z); z = MFMA32(k1, qf[1], z); z = MFMA32(k2, qf[2], z); z = MFMA32(k3, qf[3], z);
        f32x16 L;
        float g0 = 0.f, g1 = 0.f;
#pragma unroll
        for (int r = 0; r < 16; ++r) {
            const bool valid = (kt0 + keyof(r, hi)) < t;
            const float zz = z[r] * 0.125f;
            const float e = __builtin_amdgcn_exp2f(-1.4426950408889634f * fabsf(zz));
            const float lg = fminf(-zz, 0.f) - 0.6931471805599453f * __builtin_amdgcn_logf(1.0f + e);
            L[r] = valid ? lg : 0.f; z[r] = zz;
            if (r < 8) g0 += L[r]; else g1 += L[r];
        }
        const float og0 = shx(g0, 32, lane), og1 = shx(g1, 32, lane);
        float run1 = R + (hi == 0 ? og1 : 0.f);
        float run0 = R + g1 + og1 + (hi == 0 ? og0 : 0.f);
#pragma unroll
        for (int e = 7; e >= 0; --e) {
            run0 += L[e];     { const bool valid = (kt0 + keyof(e, hi)) < t;     z[e]     = valid ? __builtin_amdgcn_exp2f(1.4426950408889634f * (z[e] + run0)) : 0.f; }
            run1 += L[8 + e]; { const bool valid = (kt0 + keyof(8 + e, hi)) < t; z[8 + e] = valid ? __builtin_amdgcn_exp2f(1.4426950408889634f * (z[8 + e] + run1)) : 0.f; }
        }
        pv_acc(o, v, pack8<0>(z), pack8<1>(z));
        R += (g0 + g1) + (og0 + og1);
        if (__builtin_amdgcn_ballot_w64(R > -100.0f) == 0ull) break;
    }
    store_o(p.O + (rowb + t) * OP + 2 * 384 + h * 64, o, hi);
}

__device__ __forceinline__ void attn_phase(const AttnP& p, int lane, int bx) {
    const float* lf = p.dlam;
    float pa = (lane < 32) ? lf[lane] * lf[32 + lane] : 0.f, pb = (lane < 32) ? lf[64 + lane] * lf[96 + lane] : 0.f;
    pa = wave_sum(pa, lane); pb = wave_sum(pb, lane);
    const float lambda_init = 0.8f - 0.6f * expf(-0.3f * (float)p.layer);
    const float lam = expf(pa) - expf(pb) + lambda_init;
    const int x0 = bx & 7;
    for (int k = 0; k < 8; ++k) {
        const int xq = (x0 + k) & 7;
        unsigned* ctr = p.ctr + 64 * xq;
        for (;;) {
            unsigned u = 0;
            if (lane == 0) u = atomicAdd(ctr, 1u);
            u = (unsigned)__builtin_amdgcn_readfirstlane((int)u);
            if (u >= 9u * 256u) break;
            const int seg = (int)(u >> 8), qt = 255 - (int)(u & 255u);
            const int tyo = seg / 3, bh = xq + 8 * (seg - 3 * tyo), b = bh / NHEADS, h = bh - b * NHEADS;
            if (tyo == 0) diff_unit(p, b, h, qt, lane, lam, lambda_init);
            else if (tyo == 1) moba_unit(p, b, h, qt, lane);
            else sb_unit(p, b, h, qt, lane);
        }
    }
}
#define XB_TMO      128
#define XB_XCNT(j)  (256  + 64 * (j))
#define XB_XSUB(j)  (1280 + 64 * (j))
#define XB_XGEN(j)  (2304 + 64 * (j))
#define XB_TOP      3328
#define XB_TOPGEN   3392
#define XCD_BAR_WORDS 3456
#define XB_SPIN_CAP (1u << 18)

__device__ __forceinline__ unsigned xb_ld(unsigned* p)              { return __hip_atomic_load(p, __ATOMIC_RELAXED, __HIP_MEMORY_SCOPE_AGENT); }
__device__ __forceinline__ unsigned xb_add(unsigned* p, unsigned v) { return __hip_atomic_fetch_add(p, v, __ATOMIC_RELAXED, __HIP_MEMORY_SCOPE_AGENT); }
__device__ __forceinline__ unsigned xb_xcc_id() { return (unsigned)__builtin_amdgcn_s_getreg((3 << 11) | 20) & 0xFu; }
#define XB_SPIN(cond, bar) do { unsigned _sp = 0; while (cond) { __builtin_amdgcn_s_sleep(1); \
    if ((++_sp & 255u) == 0u) { if (xb_ld(&(bar)[XB_TMO])) break; if (_sp > XB_SPIN_CAP) { atomicAdd(&(bar)[XB_TMO], 1u); break; } } } } while (0)

struct XcdBarrier {
    unsigned* bar; unsigned x;
    volatile LAS unsigned* st;
};

__device__ __forceinline__ XcdBarrier xcd_barrier_post(unsigned* bar, volatile LAS unsigned* st) {
    XcdBarrier b; b.bar = bar; b.x = xb_xcc_id(); b.st = st;
    if (threadIdx.x == 0) (void)xb_add(&bar[XB_XCNT(b.x)], 1u);
    return b;
}
__device__ __forceinline__ void xcd_barrier_complete(unsigned* bar, unsigned x, unsigned& nloc, unsigned& nx) {
    const unsigned G = gridDim.x * gridDim.y * gridDim.z;
    unsigned sum, cnt, mine, sp = 0u;
    for (;;) {
        sum = 0u; cnt = 0u; mine = 0u;
#pragma unroll
        for (unsigned j = 0; j < 16; ++j) { const unsigned c = xb_ld(&bar[XB_XCNT(j)]); sum += c; cnt += (c > 0u) ? 1u : 0u; mine = (j == x) ? c : mine; }
        if (sum == G) break;
        __builtin_amdgcn_s_sleep(1);
        if ((++sp & 255u) == 0u) { if (xb_ld(&bar[XB_TMO])) break; if (sp > XB_SPIN_CAP) { atomicAdd(&bar[XB_TMO], 1u); break; } }
    }
    nloc = mine > 0u ? mine : 1u; nx = cnt > 0u ? cnt : 1u;
}

__device__ __forceinline__ void xcd_barrier(const XcdBarrier& b) {
    asm volatile("s_waitcnt vmcnt(0)" ::: "memory");
    __syncthreads();
    if (threadIdx.x == 0) {
        unsigned* bar = b.bar;
        __builtin_amdgcn_s_waitcnt(0);
        unsigned nloc = b.st[0], nx = b.st[1];
        if (nloc == 0u) { xcd_barrier_complete(bar, b.x, nloc, nx); b.st[0] = nloc; b.st[1] = nx; }
        const unsigned old = xb_add(&bar[XB_XSUB(b.x)], 1u);
        const unsigned gen = old / nloc;
        if (old + 1u == (gen + 1u) * nloc) {
            __builtin_amdgcn_fence(__ATOMIC_RELEASE, "agent");
            asm volatile("s_waitcnt vmcnt(0)" ::: "memory");
            const unsigned og = xb_add(&bar[XB_TOP], 1u);
            const unsigned tg = og / nx;
            if (og + 1u == (tg + 1u) * nx) xb_add(&bar[XB_TOPGEN], 1u);
            else XB_SPIN(xb_ld(&bar[XB_TOPGEN]) == tg, bar);
            __builtin_amdgcn_fence(__ATOMIC_ACQUIRE, "agent");
            xb_add(&bar[XB_XGEN(b.x)], 1u);
            asm volatile("s_waitcnt vmcnt(0)" ::: "memory");
        } else {
            XB_SPIN(xb_ld(&bar[XB_XGEN(b.x)]) == gen, bar);
            __builtin_amdgcn_fence(__ATOMIC_ACQUIRE, "agent");
            asm volatile("s_waitcnt vmcnt(0)" ::: "memory");
        }
    }
    __syncthreads();
}
__global__ void __launch_bounds__(NWAVES * 64, 2) mega_fwd(Args a) {
    extern __shared__ __attribute__((aligned(16))) unsigned char lds_raw[];
    LAS unsigned char* lds = (LAS unsigned char*)lds_raw;
    cg::grid_group grid = cg::this_grid();
    const int G = gridDim.x, NGW = G * NWAVES;
    volatile LAS unsigned* bst = (volatile LAS unsigned*)(lds + pg8::STAGE_BYTES);
    if (threadIdx.x < 2) bst[threadIdx.x] = 0u;
    __syncthreads();
    XcdBarrier bar = xcd_barrier_post((unsigned*)(a.ws + WS_CTL) + CW_BAR, bst);
    grid.sync();
    const float alpha = 1.4142135623730951f;
#pragma unroll 1
    for (int ph = 0; ph < 14 * DEPTH; ++ph) {
        const int l = ph / 14, k = ph - 14 * l;
        int tid = threadIdx.x; asm volatile("" : "+v"(tid));
        int bx = blockIdx.x; asm volatile("" : "+s"(bx));
        const int lane = tid & 63, wave = __builtin_amdgcn_readfirstlane(tid >> 6), gw = bx * NWAVES + wave;
        ArgsP ap = (ArgsP)__builtin_amdgcn_kernarg_segment_ptr(); asm volatile("" : "+s"(ap));
        unsigned char* ws = ap->ws;
        bf16_t* XB = (bf16_t*)(ws + WS_XB); bf16_t* QK = (bf16_t*)(ws + WS_QK); bf16_t* VT = (bf16_t*)(ws + WS_VT); bf16_t* OB = (bf16_t*)(ws + WS_O);
        bf16_t* MG = (bf16_t*)(ws + WS_MG); bf16_t* GB = (bf16_t*)(ws + WS_G); bf16_t* HB = (bf16_t*)(ws + WS_H);
        bf16_t* Wgu = (bf16_t*)(ws + WS_WGU); bf16_t* Wd = (bf16_t*)(ws + WS_WD); bf16_t* Win = (bf16_t*)(ws + WS_WIN); bf16_t* Wbr = (bf16_t*)(ws + WS_WBR); bf16_t* Wout = (bf16_t*)(ws + WS_WOUT);
        float* kmean = (float*)(ws + WS_KMEAN); unsigned* ctl = (unsigned*)(ws + WS_CTL);
        if (k == 0) {
            p0_convert(ap, ws, l, lds, gw, NGW, wave, lane);
        } else if (k == 1 || k == 11) {
            const int f = (k == 11);
            pg8::Gemm g{XB, Wgu + (size_t)f * 5632 * 1024, M, 5632, DM, DM, DM}; pg8::StaticOrder S; S.init(M, 5632, G, bx);
            pg8::EpiSwiGLU E{HB, DFF};
            pg8::gemm_phase<pg8::EpiSwiGLU, pg8::StaticOrder, true, true>(lds, g, S, E, tid);
        } else if (k == 2 || k == 9 || k == 12) {
            pg8::Gemm g; float beta; const float* src = ap->out;
            if (k == 9) { g = pg8::Gemm{MG, Wout, M, DM, DM, DM, DM}; beta = 1.0f; }
            else { const int f = (k == 12); g = pg8::Gemm{HB, Wd + (size_t)f * 1024 * 2816, M, DM, DFF, DFF, DFF}; beta = 0.5f; if (l == 0 && k == 2) src = ap->x; }
            pg8::StaticOrder S; S.init(M, DM, G, bx);
            pg8::EpiResid E{src, ap->out, DM, alpha, beta};
            pg8::gemm_phase<pg8::EpiResid, pg8::StaticOrder, true, true>(lds, g, S, E, tid);
        } else if (k == 3 || k == 10 || k == 13) {
            const int sub = (k == 3) ? 0 : (k == 10 ? 1 : 2);
            ln_phase(ap->out, XB, ap->ln_g + (size_t)(l * 3 + sub) * DM, ap->ln_b + (size_t)(l * 3 + sub) * DM, gw, NGW, lane);
        } else if (k == 4) {
            pg8::Gemm g{XB, Win, M, NQKVP, DM, DM, DM}; pg8::StaticOrder S; S.init(M, NQKVP, G, bx);
            pg8::EpiQKV E{QK, VT};
            pg8::gemm_phase<pg8::EpiQKV, pg8::StaticOrder, true, true>(lds, g, S, E, tid);
        } else if (k == 5) {
            kmean_phase(QK, kmean, gw, NGW, lane);
        } else if (k == 6) {
            for (int rep = 0; rep < 1; ++rep) {
            AttnP p{QK, VT, OB, kmean, ap->dlam + (size_t)l * 128, ap->subg + (size_t)l * 64, ctl + 512 * (2 * l + rep), l};
            attn_phase(p, lane, bx); }
        } else if (k == 7) {
            pg8::Gemm g{XB, Win + (size_t)NQKVP * 1024, M, NGATE, DM, DM, DM}; pg8::StaticOrder S; S.init(M, NGATE, G, bx);
            pg8::EpiGate E{GB, ap->b_gate + (size_t)l * NGATE};
            pg8::gemm_phase<pg8::EpiGate, pg8::StaticOrder, true, true>(lds, g, S, E, tid);
        } else if (k == 8) {
            pg8::Gemm g{OB, Wbr, M, NGATE, 384, OP, 384}; pg8::BranchOrder S{G, bx};
            pg8::EpiBranch E{MG, GB};
            pg8::gemm_phase<pg8::EpiBranch, pg8::BranchOrder, true, true>(lds, g, S, E, tid);
        }
        xcd_barrier(bar);
    }
}

extern "C" void kernel_launch(void* const* d_in, const int* in_sizes, int n_in, void* d_out, int out_size, void* d_ws, size_t ws_size, hipStream_t stream) {
    static int grid = 0;
    if (grid == 0) {
        if (n_in != 14 || in_sizes[0] != M * DM || out_size != M * DM || ws_size < WS_END) { fprintf(stderr, "kernel_launch: unexpected shapes (n_in %d, in0 %d, out %d, ws %zu)\n", n_in, n_in > 0 ? in_sizes[0] : -1, out_size, ws_size); grid = -1; return; }
        int dev = 0, cus = 0, per_cu = 0;
        if (hipGetDevice(&dev) != hipSuccess || hipDeviceGetAttribute(&cus, hipDeviceAttributeMultiprocessorCount, dev) != hipSuccess) { grid = -1; return; }
        if (hipFuncSetAttribute((const void*)mega_fwd, hipFuncAttributeMaxDynamicSharedMemorySize, LDS_BYTES) != hipSuccess) { fprintf(stderr, "kernel_launch: hipFuncSetAttribute failed\n"); grid = -1; return; }
        if (hipOccupancyMaxActiveBlocksPerMultiprocessor(&per_cu, (const void*)mega_fwd, NWAVES * 64, LDS_BYTES) != hipSuccess || per_cu < 1) { fprintf(stderr, "kernel_launch: occupancy query says %d\n", per_cu); per_cu = 1; }
        (void)hipGetLastError();
        grid = cus * per_cu;
    }
    if (grid < 0) return;
    (void)hipMemsetAsync((char*)d_ws + WS_CTL, 0, CTL_ZERO_BYTES, stream);
    Args a{};
    a.x = (const float*)d_in[0]; a.ln_g = (const float*)d_in[1]; a.ln_b = (const float*)d_in[2]; a.w_gate = (const float*)d_in[3]; a.w_up = (const float*)d_in[4];
    a.w_down = (const float*)d_in[5]; a.w_in = (const float*)d_in[6]; a.b_gate = (const float*)d_in[7]; a.dlam = (const float*)d_in[8]; a.subg = (const float*)d_in[9];
    a.w_brm = (const float*)d_in[10]; a.w_brd = (const float*)d_in[11]; a.w_brs = (const float*)d_in[12]; a.w_out = (const float*)d_in[13];
    a.out = (float*)d_out; a.ws = (unsigned char*)d_ws;
    void* args[] = {&a};
    hipError_t e = hipLaunchCooperativeKernel((const void*)mega_fwd, dim3(grid), dim3(NWAVES * 64), args, LDS_BYTES, stream);
    if (e != hipSuccess) fprintf(stderr, "kernel_launch: cooperative launch failed: %s (grid %d)\n", hipGetErrorString(e), grid);
}
```

```cpp
#include <hip/hip_runtime.h>
#include <hip/hip_cooperative_groups.h>
#include <cstdio>
#include <cstdint>
#include <cmath>
namespace cg = cooperative_groups;
namespace pg8 {
#define PG8_LAS __attribute__((address_space(3)))
typedef unsigned short bf16_t;
typedef short bf16x8 __attribute__((ext_vector_type(8)));
typedef float f32x4 __attribute__((ext_vector_type(4)));
typedef unsigned u32x4 __attribute__((ext_vector_type(4)));
constexpr int BM = 256, BK = 64, HALF = 128, HTB = HALF * BK * 2  , STAGE_BYTES = 8 * HTB, NXCD = 8, WGM = 8;

__host__ __device__ __forceinline__ int lds_byte(int r, int c) { const int st = (r >> 4) * 2 + (c >> 5), rr = r & 15, cc = c & 31, ob = rr * 64 + cc * 2; return st * 1024 + (ob ^ (((ob >> 9) & 1) << 5)); }
__host__ __device__ __forceinline__ void stage_rc(int b, int& R, int& C) { const int st = b / 1024, sb = b % 1024, swz = sb ^ (((sb >> 9) & 1) << 5); R = (st >> 1) * 16 + swz / 64; C = (st & 1) * 32 + (swz % 64) / 2; }
__host__ __device__ __forceinline__ int perm32(int rho) { const int n = rho >> 4, i = rho & 15; return 8 * (i >> 2) + 4 * n + (i & 3); }

struct Unit { int pm, pn, aoff; };
struct Gemm { const bf16_t* A; const bf16_t* Bt; int M, N, K, lda, ldb; };

struct StaticOrder {
    int nM, nN, nwg, G, c;
    __host__ __device__ void init(int M, int N, int G_, int c_) { nM = M / BM; nN = N / BM; nwg = nM * nN; G = G_; c = c_; }
    __host__ __device__ bool next(int i, Unit& u) const {
        const long L = (long)i * G + c; if (L >= nwg) return false;
        int wgid = (int)L; { const int q = nwg / NXCD, r = nwg % NXCD, xcd = wgid % NXCD, off = wgid / NXCD; wgid = (xcd < r ? xcd * (q + 1) : r * (q + 1) + (xcd - r) * q) + off; }
        const int nig = WGM * nN, gid = wgid / nig, fm = gid * WGM, gsz = (nM - fm) < WGM ? (nM - fm) : WGM;
        u.pm = fm + ((wgid % nig) % gsz); u.pn = (wgid % nig) / gsz; u.aoff = 0; return true;
    }
    __device__ __forceinline__ void a_ready(const Unit&) const {}
    __device__ __forceinline__ void done(const Unit&) const {}
};

typedef float f32x2c_t __attribute__((ext_vector_type(2))); typedef __bf16 bf16x2c_t __attribute__((ext_vector_type(2)));
__device__ __forceinline__ unsigned cvt_pk_bf16(float lo, float hi) { f32x2c_t v = {lo, hi}; bf16x2c_t b = __builtin_convertvector(v, bf16x2c_t); return __builtin_bit_cast(unsigned, b); }
typedef float f32x2 __attribute__((ext_vector_type(2)));
__device__ __forceinline__ float bf2f(unsigned short v) { return __uint_as_float(((unsigned)v) << 16); }
__device__ __forceinline__ float bflo(unsigned v) { return __uint_as_float(v << 16); }
__device__ __forceinline__ float bfhi(unsigned v) { return __uint_as_float(v & 0xffff0000u); }
__device__ __forceinline__ float fast_sigmoid(float v) { return __builtin_amdgcn_rcpf(1.0f + __builtin_amdgcn_exp2f(-1.4426950408889634f * v)); }

struct EpiSwiGLU {
    static constexpr bool PERM = true, AFTER_DRAIN = false;
    bf16_t* H; int ldh;
    __device__ __forceinline__ void operator()(const f32x4 (&acc)[2][2][4][2], const Unit& u, int wr, int wc, int fr, int fq) const {
        const int row0 = u.pm * BM + wr * 64 + fr, col0 = u.pn * HALF + wc * 32 + 8 * fq;
#pragma unroll
        for (int ai = 0; ai < 2; ++ai)
#pragma unroll
            for (int m = 0; m < 4; ++m) {
                bf16_t* rowp = H + (size_t)(row0 + ai * HALF + m * 16) * ldh + col0;
                float h[8];
#pragma unroll
                for (int n = 0; n < 2; ++n)
#pragma unroll
                    for (int i = 0; i < 4; ++i) { const float g = acc[ai][0][m][n][i], up = acc[ai][1][m][n][i]; h[4 * n + i] = g * fast_sigmoid(g) * up; }
                u32x4 w; w.x = cvt_pk_bf16(h[0], h[1]); w.y = cvt_pk_bf16(h[2], h[3]); w.z = cvt_pk_bf16(h[4], h[5]); w.w = cvt_pk_bf16(h[6], h[7]);
                *(u32x4*)rowp = w;
            }
    }
};
struct EpiResid {
    static constexpr bool PERM = false, AFTER_DRAIN = false;
    const float* src; float* out; int ldc; float a, bsc;
    __device__ __forceinline__ void operator()(const f32x4 (&acc)[2][2][4][2], const Unit& u, int wr, int wc, int fr, int fq) const {
        const int row0 = u.pm * BM + wr * 64 + fr, col0 = u.pn * BM + wc * 32 + 4 * fq;
#pragma unroll
        for (int ai = 0; ai < 2; ++ai)
#pragma unroll
            for (int m = 0; m < 4; ++m) {
                const size_t off = (size_t)(row0 + ai * HALF + m * 16) * ldc + col0;
#pragma unroll
                for (int bj = 0; bj < 2; ++bj)
#pragma unroll
                    for (int n = 0; n < 2; ++n) { const f32x4 s = *(const f32x4*)(src + off + bj * HALF + n * 16); *(f32x4*)(out + off + bj * HALF + n * 16) = s * a + acc[ai][bj][m][n] * bsc; }
                if (m & 1) asm volatile("" ::: "memory");
            }
    }
};
struct EpiQKV {
    static constexpr bool PERM = true, AFTER_DRAIN = false;
    bf16_t* QK; bf16_t* VT;
    __device__ __forceinline__ void operator()(const f32x4 (&acc)[2][2][4][2], const Unit& u, int wr, int wc, int fr, int fq) const {
        const int row0 = u.pm * BM + wr * 64 + fr;
        if (u.pn < 9) {
            const int col0 = u.pn * BM + wc * 32 + 8 * fq;
#pragma unroll
            for (int ai = 0; ai < 2; ++ai)
#pragma unroll
                for (int m = 0; m < 4; ++m) { bf16_t* rowp = QK + (size_t)(row0 + ai * HALF + m * 16) * 2304 + col0;
#pragma unroll
                    for (int bj = 0; bj < 2; ++bj) {
                        const int seg = (2 * u.pn + bj) / 3;
                        const float sc = seg == 0 ? 0.125f * 1.4426950408889634f : (seg == 2 ? 0.17677669529663687f * 1.4426950408889634f : (seg == 4 ? 0.125f : 1.0f));
                        const f32x4 v0 = acc[ai][bj][m][0] * sc, v1 = acc[ai][bj][m][1] * sc;
                        u32x4 w; w.x = cvt_pk_bf16(v0[0], v0[1]); w.y = cvt_pk_bf16(v0[2], v0[3]); w.z = cvt_pk_bf16(v1[0], v1[1]); w.w = cvt_pk_bf16(v1[2], v1[3]);
                        *(u32x4*)(rowp + bj * HALF) = w; } }
        } else {
            const int bb = (u.pm * BM) >> 13;
            const int s0 = ((u.pm * BM) & 8191) + wr * 64 + fr;
            const int dd = 32 * (wc & 1) + 8 * fq;
#pragma unroll
            for (int bj = 0; bj < 2; ++bj) {
                const int gh = 4 * (u.pn - 9) + 2 * bj + (wc >> 1);
                if (gh < 18) {
                    const int ty = gh / 6, hh = gh - 6 * ty;
                    bf16_t* base = VT + ((size_t)(((ty * 4 + bb) * 6 + hh) * 64 + dd)) * 8192 + s0;
#pragma unroll
                    for (int ai = 0; ai < 2; ++ai)
#pragma unroll
                        for (int m = 0; m < 4; ++m)
#pragma unroll
                            for (int n = 0; n < 2; ++n) { const f32x4 v = acc[ai][bj][m][n]; const unsigned w0 = cvt_pk_bf16(v[0], v[1]), w1 = cvt_pk_bf16(v[2], v[3]);
                                bf16_t* pp = base + (size_t)(4 * n) * 8192 + ai * HALF + m * 16;
                                pp[0] = (bf16_t)(w0 & 0xffffu); pp[8192] = (bf16_t)(w0 >> 16); pp[2 * 8192] = (bf16_t)(w1 & 0xffffu); pp[3 * 8192] = (bf16_t)(w1 >> 16); }
                }
            }
        }
    }
};
struct EpiGate {
    static constexpr bool PERM = true, AFTER_DRAIN = false;
    bf16_t* G; const float* bias;
    __device__ __forceinline__ void operator()(const f32x4 (&acc)[2][2][4][2], const Unit& u, int wr, int wc, int fr, int fq) const {
        const int row0 = u.pm * BM + wr * 64 + fr, col0 = u.pn * BM + wc * 32 + 8 * fq;
        f32x4 bv[2][2];
#pragma unroll
        for (int bj = 0; bj < 2; ++bj)
#pragma unroll
            for (int n = 0; n < 2; ++n) bv[bj][n] = *(const f32x4*)(bias + col0 + bj * HALF + 4 * n);
#pragma unroll
        for (int ai = 0; ai < 2; ++ai)
#pragma unroll
            for (int m = 0; m < 4; ++m) { bf16_t* rowp = G + (size_t)(row0 + ai * HALF + m * 16) * 3072 + col0;
#pragma unroll
                for (int bj = 0; bj < 2; ++bj) { const f32x4 v0 = acc[ai][bj][m][0] + bv[bj][0], v1 = acc[ai][bj][m][1] + bv[bj][1];
                    u32x4 w; w.x = cvt_pk_bf16(fast_sigmoid(v0[0]), fast_sigmoid(v0[1])); w.y = cvt_pk_bf16(fast_sigmoid(v0[2]), fast_sigmoid(v0[3]));
                    w.z = cvt_pk_bf16(fast_sigmoid(v1[0]), fast_sigmoid(v1[1])); w.w = cvt_pk_bf16(fast_sigmoid(v1[2]), fast_sigmoid(v1[3]));
                    *(u32x4*)(rowp + bj * HALF) = w; } }
    }
};
struct EpiBranch {
    static constexpr bool PERM = true, AFTER_DRAIN = false;
    bf16_t* Mg; const bf16_t* G;
    __device__ __forceinline__ void operator()(const f32x4 (&acc)[2][2][4][2], const Unit& u, int wr, int wc, int fr, int fq) const {
        const int br = u.pn >> 2, pq = u.pn & 3;
        const int row0 = u.pm * BM + wr * 64 + fr, gcol0 = u.pn * BM + wc * 32 + 8 * fq, mcol0 = pq * BM + wc * 32 + 8 * fq;
#pragma unroll
        for (int ai = 0; ai < 2; ++ai)
#pragma unroll
            for (int m = 0; m < 4; ++m) { const size_t r = (size_t)(row0 + ai * HALF + m * 16);
#pragma unroll
                for (int bj = 0; bj < 2; ++bj) {
                    const u32x4 gv = *(const u32x4*)(G + r * 3072 + gcol0 + bj * HALF);
                    bf16_t* mp = Mg + r * 1024 + mcol0 + bj * HALF;
                    const f32x4 v0 = acc[ai][bj][m][0], v1 = acc[ai][bj][m][1];
                    float o[8] = { bflo(gv.x) * v0[0], bfhi(gv.x) * v0[1], bflo(gv.y) * v0[2], bfhi(gv.y) * v0[3], bflo(gv.z) * v1[0], bfhi(gv.z) * v1[1], bflo(gv.w) * v1[2], bfhi(gv.w) * v1[3] };
                    if (br > 0) { const u32x4 ov = *(const u32x4*)mp;
                        o[0] += bflo(ov.x); o[1] += bfhi(ov.x); o[2] += bflo(ov.y); o[3] += bfhi(ov.y); o[4] += bflo(ov.z); o[5] += bfhi(ov.z); o[6] += bflo(ov.w); o[7] += bfhi(ov.w); }
                    u32x4 w; w.x = cvt_pk_bf16(o[0], o[1]); w.y = cvt_pk_bf16(o[2], o[3]); w.z = cvt_pk_bf16(o[4], o[5]); w.w = cvt_pk_bf16(o[6], o[7]);
                    *(u32x4*)mp = w; }
                asm volatile("" ::: "memory"); }
    }
};
struct BranchOrder {
    int G, c;
    __device__ bool next(int i, Unit& u) const {
        const int ti = (i / 3) * G + c, br = i - 3 * (i / 3);
        if (ti >= 512) return false;
        u.pm = ti >> 2; u.pn = br * 4 + (ti & 3); u.aoff = br * 384 * 2; return true;
    }
    __device__ __forceinline__ void a_ready(const Unit&) const {}
    __device__ __forceinline__ void done(const Unit&) const {}
};

template <class Epi, class Sched, bool ALIGN_EPI = false, bool SP2 = false>
__device__ __forceinline__ void gemm_phase(PG8_LAS unsigned char* lds, const Gemm g, const Sched& S, const Epi& E, const int tid_in) {
    int tid = tid_in; asm volatile("" : "+v"(tid));
    const int wid = __builtin_amdgcn_readfirstlane(tid >> 6), lane = tid & 63, wr = wid >> 2, wc = wid & 3, fr = lane & 15, fq = lane >> 4;
    const int K = g.K, nt = K / BK;
    unsigned voffA[2], voffB[2];
#pragma unroll
    for (int i = 0; i < 2; ++i) { int R, C; stage_rc(tid * 16 + i * 8192, R, C); const int Rb = Epi::PERM ? ((R & ~31) + perm32(R & 31)) : R;
        voffA[i] = (unsigned)(R * g.lda + C) * 2u; voffB[i] = (unsigned)(Rb * g.ldb + C) * 2u; }
    const size_t kstep = (size_t)(BK * 2);
    const size_t hstepA = (size_t)HALF * g.lda * 2, hstepB = (size_t)HALF * g.ldb * 2;
    const size_t tstepA = 2 * hstepA, tstepB = 2 * hstepB;
    const unsigned ldsw = (unsigned)wid * 1024u;
    const int aoff = lds_byte(wr * 64 + fr, fq * 8), boff = lds_byte(wc * 32 + fr, fq * 8);
#define PG8_SA(b, h) (((b) * 2 + (h)) * HTB)
#define PG8_SB(b, h) ((4 + (b) * 2 + (h)) * HTB)
#define PG8_STAGE(bufoff, gbase, voff) do { _Pragma("unroll") for (int _i = 0; _i < 2; ++_i) \
        __builtin_amdgcn_global_load_lds((const unsigned*)((const char*)(gbase) + (voff)[_i]), (PG8_LAS unsigned*)(lds + (bufoff) + ldsw + _i * 8192), 16, 0, 0); } while (0)
#define PG8_LDA(dst, b, h) do { _Pragma("unroll") for (int m = 0; m < 4; ++m) _Pragma("unroll") for (int k = 0; k < 2; ++k) dst[m][k] = *(const PG8_LAS bf16x8*)(lds + PG8_SA(b, h) + aoff + m * 2048 + k * 1024); } while (0)
#define PG8_LDB(dst, b, h) do { _Pragma("unroll") for (int n = 0; n < 2; ++n) _Pragma("unroll") for (int k = 0; k < 2; ++k) dst[n][k] = *(const PG8_LAS bf16x8*)(lds + PG8_SB(b, h) + boff + n * 2048 + k * 1024); } while (0)
#define PG8_MMA(ai, bj, At, Bt) do { __builtin_amdgcn_s_setprio(1); _Pragma("unroll") for (int m = 0; m < 4; ++m) _Pragma("unroll") for (int n = 0; n < 2; ++n) _Pragma("unroll") for (int k = 0; k < 2; ++k) \
        acc[ai][bj][m][n] = __builtin_amdgcn_mfma_f32_16x16x32_bf16(Bt[n][k], At[m][k], acc[ai][bj][m][n], 0, 0, 0); __builtin_amdgcn_s_setprio(0); } while (0)
#define PG8_WAIT_V(n) asm volatile("s_waitcnt vmcnt(" #n ")" ::: "memory")
#define PG8_WAIT_L(n) asm volatile("s_waitcnt lgkmcnt(" #n ")" ::: "memory")
#define PG8_BAR __builtin_amdgcn_s_barrier()
#define PG8_SCHED __builtin_amdgcn_sched_barrier(0)
    Unit cur, nxt; int ui = 0;
    if (!S.next(0, cur)) return;
    f32x4 acc[2][2][4][2];
#pragma unroll
    for (int a = 0; a < 2; ++a)
#pragma unroll
        for (int b = 0; b < 2; ++b)
#pragma unroll
            for (int m = 0; m < 4; ++m)
#pragma unroll
                for (int n = 0; n < 2; ++n) acc[a][b][m][n] = (f32x4){0.f, 0.f, 0.f, 0.f};
    bf16x8 At[4][2], B0[2][2], B1[2][2];
    const char* cA = (const char*)g.A + (size_t)cur.pm * tstepA + cur.aoff; const char* cB = (const char*)g.Bt + (size_t)cur.pn * tstepB;
    S.a_ready(cur);
    if constexpr (SP2) {
        PG8_STAGE(PG8_SB(0, 0), cB, voffB); PG8_STAGE(PG8_SB(0, 1), cB + hstepB, voffB); PG8_STAGE(PG8_SA(0, 0), cA, voffA); PG8_STAGE(PG8_SA(0, 1), cA + hstepA, voffA);
        if (wr == 1) PG8_BAR;
        PG8_WAIT_V(2); PG8_BAR;
        PG8_STAGE(PG8_SB(1, 0), cB + kstep, voffB); PG8_STAGE(PG8_SA(1, 0), cA + kstep, voffA); PG8_STAGE(PG8_SB(1, 1), cB + hstepB + kstep, voffB);
        PG8_WAIT_V(6); PG8_BAR;
    } else {
        PG8_STAGE(PG8_SB(0, 0), cB, voffB); PG8_STAGE(PG8_SA(0, 0), cA, voffA); PG8_STAGE(PG8_SB(0, 1), cB + hstepB, voffB); PG8_STAGE(PG8_SA(0, 1), cA + hstepA, voffA);
        if (wr == 1) PG8_BAR;
        PG8_WAIT_V(4); PG8_BAR;
        PG8_STAGE(PG8_SB(1, 0), cB + kstep, voffB); PG8_STAGE(PG8_SA(1, 0), cA + kstep, voffA); PG8_STAGE(PG8_SB(1, 1), cB + hstepB + kstep, voffB);
        PG8_WAIT_V(6); PG8_BAR;
    }
    for (;;) {
        const bool has_next = S.next(ui + 1, nxt);
        const char* nA = has_next ? (const char*)g.A + (size_t)nxt.pm * tstepA + nxt.aoff : cA; const char* nB = has_next ? (const char*)g.Bt + (size_t)nxt.pn * tstepB : cB;
        for (int t = 0; t < nt; t += 2) {
            const bool last = (t == nt - 2);
            const char* a1 = cA + (size_t)(t + 1) * kstep;
            const char* a2 = last ? nA : cA + (size_t)(t + 2) * kstep; const char* b2 = last ? nB : cB + (size_t)(t + 2) * kstep;
            const char* a3 = a2 + kstep; const char* b3 = b2 + kstep;
            if (last && has_next) S.a_ready(nxt);
            if constexpr (SP2) {
            PG8_LDB(B0, 0, 0); PG8_LDB(B1, 0, 1); PG8_SCHED; PG8_LDA(At, 0, 0); PG8_STAGE(PG8_SA(1, 1), a1 + hstepA, voffA);
            PG8_WAIT_V(8); PG8_WAIT_L(0); PG8_BAR; PG8_MMA(0, 0, At, B0); PG8_MMA(0, 1, At, B1); PG8_BAR; PG8_SCHED;
            PG8_LDA(At, 0, 1); PG8_STAGE(PG8_SB(0, 0), b2, voffB); PG8_STAGE(PG8_SB(0, 1), b2 + hstepB, voffB); PG8_STAGE(PG8_SA(0, 0), a2, voffA);
            PG8_WAIT_V(8); PG8_WAIT_L(0); PG8_BAR; PG8_MMA(1, 0, At, B0); PG8_MMA(1, 1, At, B1); PG8_BAR; PG8_SCHED;
            PG8_LDB(B0, 1, 0); PG8_LDB(B1, 1, 1); PG8_SCHED; PG8_LDA(At, 1, 0); PG8_STAGE(PG8_SA(0, 1), a2 + hstepA, voffA);
            PG8_WAIT_V(8); PG8_WAIT_L(0); PG8_BAR; PG8_MMA(0, 0, At, B0); PG8_MMA(0, 1, At, B1); PG8_BAR; PG8_SCHED;
            PG8_LDA(At, 1, 1); PG8_STAGE(PG8_SB(1, 0), b3, voffB); PG8_STAGE(PG8_SB(1, 1), b3 + hstepB, voffB); PG8_STAGE(PG8_SA(1, 0), a3, voffA);
            PG8_WAIT_V(8); PG8_WAIT_L(0); PG8_BAR; PG8_MMA(1, 0, At, B0); PG8_MMA(1, 1, At, B1); PG8_BAR; PG8_SCHED;
            } else {
            PG8_LDB(B0, 0, 0); PG8_SCHED; PG8_LDA(At, 0, 0); PG8_STAGE(PG8_SA(1, 1), a1 + hstepA, voffA);
            PG8_WAIT_L(8); PG8_BAR; PG8_WAIT_L(0); PG8_MMA(0, 0, At, B0); PG8_BAR; PG8_SCHED;
            PG8_LDB(B1, 0, 1); PG8_STAGE(PG8_SB(0, 0), b2, voffB);
            PG8_BAR; PG8_WAIT_L(0); PG8_MMA(0, 1, At, B1); PG8_BAR;
            PG8_LDA(At, 0, 1); PG8_STAGE(PG8_SA(0, 0), a2, voffA);
            PG8_BAR; PG8_WAIT_L(0); PG8_MMA(1, 0, At, B0); PG8_BAR; PG8_SCHED;
            PG8_STAGE(PG8_SB(0, 1), b2 + hstepB, voffB);
            PG8_WAIT_V(6); PG8_BAR; PG8_MMA(1, 1, At, B1); PG8_BAR;
            PG8_LDB(B0, 1, 0); PG8_SCHED; PG8_LDA(At, 1, 0); PG8_STAGE(PG8_SA(0, 1), a2 + hstepA, voffA);
            PG8_WAIT_L(8); PG8_BAR; PG8_WAIT_L(0); PG8_MMA(0, 0, At, B0); PG8_BAR; PG8_SCHED;
            PG8_LDB(B1, 1, 1); PG8_STAGE(PG8_SB(1, 0), b3, voffB);
            PG8_BAR; PG8_WAIT_L(0); PG8_MMA(0, 1, At, B1); PG8_BAR;
            PG8_LDA(At, 1, 1); PG8_STAGE(PG8_SA(1, 0), a3, voffA);
            PG8_BAR; PG8_WAIT_L(0); PG8_MMA(1, 0, At, B0); PG8_BAR; PG8_SCHED;
            PG8_STAGE(PG8_SB(1, 1), b3 + hstepB, voffB);
            PG8_WAIT_V(6); PG8_BAR; PG8_MMA(1, 1, At, B1); PG8_BAR;
            }
        }
        if constexpr (ALIGN_EPI) { if (wr == 0) PG8_BAR; }
        if constexpr (!Epi::AFTER_DRAIN) { int ln_; asm volatile("v_mbcnt_lo_u32_b32 %0, -1, 0\n\tv_mbcnt_hi_u32_b32 %0, -1, %0" : "=v"(ln_)); const int fr_ = ln_ & 15, fq_ = ln_ >> 4; E(acc, cur, wr, wc, fr_, fq_); S.done(cur); }
        if (!has_next) break;
#pragma unroll
        for (int a = 0; a < 2; ++a)
#pragma unroll
            for (int b = 0; b < 2; ++b)
#pragma unroll
                for (int m = 0; m < 4; ++m)
#pragma unroll
                    for (int n = 0; n < 2; ++n) acc[a][b][m][n] = (f32x4){0.f, 0.f, 0.f, 0.f};
        cur = nxt; cA = nA; cB = nB; ++ui;
        if constexpr (ALIGN_EPI) { if (wr == 1) PG8_BAR; }
    }
    PG8_WAIT_V(0);
    if constexpr (!ALIGN_EPI) { if (wr == 0) PG8_BAR; }
    PG8_BAR;
    if constexpr (Epi::AFTER_DRAIN) { E.fused(acc, cur, wr, wc, fr, fq, lds, wid, lane); S.done(cur); }
#undef PG8_SA
#undef PG8_SB
#undef PG8_STAGE
#undef PG8_LDA
#undef PG8_LDB
#undef PG8_MMA
#undef PG8_WAIT_V
#undef PG8_WAIT_L
#undef PG8_BAR
#undef PG8_SCHED
}
}
using pg8::bf16_t; using pg8::bf16x8; using pg8::f32x4; using pg8::u32x4;
typedef float f32x16 __attribute__((ext_vector_type(16)));
typedef unsigned u32x2 __attribute__((ext_vector_type(2)));
#define LAS __attribute__((address_space(3)))
constexpr int NWAVES = 8;
constexpr int DM = 1024, NBATCH = 4, SEQ = 8192, DEPTH = 2, DFF = 2816, NHEADS = 6;
constexpr int M = NBATCH * SEQ;
constexpr int NIN = 6528, NQKVP = 3584, NGATE = 3072, QKP = 2304, OP = 1152;
constexpr float LN_EPS = 1e-5f, SUBLN_EPS = 1e-5f;
constexpr size_t MiB = 1u << 20;
constexpr size_t WS_CTL = 0, CTL_ZERO_BYTES = 32768;
constexpr int CW_BAR = 2048;
constexpr size_t WS_KMEAN = 256 * 1024;
constexpr size_t WS_WGU = 1 * MiB;
constexpr size_t WS_WD = WS_WGU + 2 * (size_t)5632 * 1024 * 2;
constexpr size_t WS_WIN = WS_WD + 2 * (size_t)1024 * 2816 * 2;
constexpr size_t WS_WBR = WS_WIN + (size_t)6656 * 1024 * 2;
constexpr size_t WS_WOUT = WS_WBR + (size_t)3072 * 384 * 2;
constexpr size_t WS_WEND = WS_WOUT + (size_t)1024 * 1024 * 2;
constexpr size_t WS_XB = 52 * MiB;
constexpr size_t WS_QK = 116 * MiB;
constexpr size_t WS_VT = 260 * MiB;
constexpr size_t WS_O = 332 * MiB;
constexpr size_t WS_MG = 404 * MiB;
constexpr size_t WS_G = 116 * MiB;
constexpr size_t WS_H = 116 * MiB;
constexpr size_t WS_END = 468 * MiB;
static_assert(WS_WEND <= WS_XB && WS_XB + (size_t)M * DM * 2 <= WS_QK && WS_QK + (size_t)M * QKP * 2 <= WS_VT && WS_VT + (size_t)72 * MiB <= WS_O && WS_O + (size_t)M * OP * 2 <= WS_MG && WS_MG + (size_t)M * DM * 2 <= WS_END, "ws map");
static_assert(WS_G + (size_t)M * NGATE * 2 <= WS_O && WS_H + (size_t)M * DFF * 2 <= WS_O, "overlay");
constexpr int LDS_BYTES = pg8::STAGE_BYTES + 256;

struct Args {
    const float *x, *ln_g, *ln_b, *w_gate, *w_up, *w_down, *w_in, *b_gate, *dlam, *subg, *w_brm, *w_brd, *w_brs, *w_out;
    float* out; unsigned char* ws;
};

__device__ __forceinline__ unsigned f2bf(float f) { unsigned u = __builtin_bit_cast(unsigned, f); return (u + 0x7fffu + ((u >> 16) & 1u)) >> 16; }
__device__ __forceinline__ unsigned pk2(float lo, float hi) { return f2bf(lo) | (f2bf(hi) << 16); }
__device__ __forceinline__ float shx(float v, int mask, int lane) { return __int_as_float(__builtin_amdgcn_ds_bpermute((lane ^ mask) << 2, __float_as_int(v))); }
__device__ __forceinline__ float wave_sum(float v, int lane) {
#pragma unroll
    for (int o = 1; o < 64; o <<= 1) v += shx(v, o, lane);
    return v;
}
__device__ __forceinline__ void p0_item(const float* W, int K, int N, bf16_t* WT, int k0, int n0, int drow, LAS float* scr, int lane) {
#pragma unroll 8
    for (int i = 0; i < 32; ++i) { const int kk = 2 * i + (lane >> 5); scr[kk * 33 + (lane & 31)] = W[(size_t)(k0 + kk) * N + n0 + (lane & 31)]; }
    asm volatile("s_waitcnt lgkmcnt(0)" ::: "memory");
    const int c = lane & 7;
#pragma unroll
    for (int j = 0; j < 4; ++j) { const int n = (lane >> 3) + 8 * j; const LAS float* s = scr + (8 * c) * 33 + n;
        u32x4 o; o.x = pk2(s[0 * 33], s[1 * 33]); o.y = pk2(s[2 * 33], s[3 * 33]); o.z = pk2(s[4 * 33], s[5 * 33]); o.w = pk2(s[6 * 33], s[7 * 33]);
        *(u32x4*)(WT + (size_t)(drow + n) * K + k0 + 8 * c) = o; }
    asm volatile("s_waitcnt lgkmcnt(0)" ::: "memory");
}
typedef const __attribute__((address_space(4))) Args* ArgsP;
__device__ __forceinline__ void p0_convert(ArgsP a, unsigned char* ws, int l, LAS unsigned char* lds, int gw, int NGW, int wave, int lane) {
    LAS float* scr = (LAS float*)(lds + wave * 16384);
    constexpr int I_G = 2 * 16 * 88, I_D = 2 * 44 * 32, I_IN = 16 * 204, I_BR = 3 * 6 * 32, I_O = 16 * 32;
    constexpr int NITEMS = 2 * I_G + I_D + I_IN + I_BR + I_O;
    for (int it = gw; it < NITEMS; it += NGW) {
        int r = it;
        if (r < 2 * I_G) {
            const int up = r >= I_G; if (up) r -= I_G;
            const int f = r / (16 * 88); r -= f * (16 * 88);
            const int kb = r / 88, nb = r - kb * 88, n0 = 32 * nb;
            const float* W = (up ? a->w_up : a->w_gate) + (size_t)(l * 2 + f) * DM * DFF;
            bf16_t* WT = (bf16_t*)(ws + WS_WGU) + (size_t)f * 5632 * 1024;
            p0_item(W, DM, DFF, WT, 64 * kb, n0, 256 * (n0 >> 7) + 128 * up + (n0 & 127), scr, lane);
            continue;
        }
        r -= 2 * I_G;
        if (r < I_D) {
            const int f = r / (44 * 32); r -= f * (44 * 32);
            const int kb = r / 32, nb = r - kb * 32;
            p0_item(a->w_down + (size_t)(l * 2 + f) * DFF * DM, DFF, DM, (bf16_t*)(ws + WS_WD) + (size_t)f * 1024 * 2816, 64 * kb, 32 * nb, 32 * nb, scr, lane);
            continue;
        }
        r -= I_D;
        if (r < I_IN) {
            const int kb = r / 204, nb = r - kb * 204, n0 = 32 * nb;
            int drow;
            if (n0 < 3456) { const int seg = n0 / 384, rem = n0 - seg * 384, ty = seg / 3, qkv = seg - 3 * ty; drow = (qkv < 2 ? ty * 768 + qkv * 384 : 2304 + ty * 384) + rem; }
            else drow = n0 + 128;
            p0_item(a->w_in + (size_t)l * DM * NIN, DM, NIN, (bf16_t*)(ws + WS_WIN), 64 * kb, n0, drow, scr, lane);
            continue;
        }
        r -= I_IN;
        if (r < I_BR) {
            const int br = r / (6 * 32); r -= br * (6 * 32);
            const int kb = r / 32, nb = r - kb * 32;
            const float* W = (br == 0 ? a->w_brm : (br == 1 ? a->w_brd : a->w_brs)) + (size_t)l * 384 * DM;
            p0_item(W, 384, DM, (bf16_t*)(ws + WS_WBR), 64 * kb, 32 * nb, br * 1024 + 32 * nb, scr, lane);
            continue;
        }
        r -= I_BR;
        { const int kb = r / 32, nb = r - kb * 32;
          p0_item(a->w_out + (size_t)l * DM * DM, DM, DM, (bf16_t*)(ws + WS_WOUT), 64 * kb, 32 * nb, 32 * nb, scr, lane); }
    }
    if (l == 0) {
        bf16_t* XB = (bf16_t*)(ws + WS_XB);
        for (int m = gw; m < M; m += NGW) {
            const f32x4* xr = (const f32x4*)(a->x + (size_t)m * DM) + lane; u32x2* o8 = (u32x2*)(XB + (size_t)m * DM) + lane;
#pragma unroll
            for (int j = 0; j < 4; ++j) { const f32x4 v = xr[64 * j]; u32x2 w; w.x = pk2(v.x, v.y); w.y = pk2(v.z, v.w); o8[64 * j] = w; }
        }
    }
}
__device__ __forceinline__ void ln_phase(float* out, bf16_t* XB, const float* g, const float* b, int gw, int NGW, int lane) {
    f32x4 gv[4], bv[4];
#pragma unroll
    for (int j = 0; j < 4; ++j) { gv[j] = ((const f32x4*)g)[lane + 64 * j]; bv[j] = ((const f32x4*)b)[lane + 64 * j]; }
    for (int m = gw; m < M; m += NGW) {
        f32x4* xr = (f32x4*)(out + (size_t)m * DM) + lane; u32x2* o8 = (u32x2*)(XB + (size_t)m * DM) + lane;
        f32x4 v[4]; float s = 0.f;
#pragma unroll
        for (int j = 0; j < 4; ++j) { v[j] = xr[64 * j]; s += (v[j].x + v[j].y) + (v[j].z + v[j].w); }
        const float mean = wave_sum(s, lane) * (1.f / DM); float s2 = 0.f;
#pragma unroll
        for (int j = 0; j < 4; ++j) { v[j] = v[j] - mean; s2 += (v[j].x * v[j].x + v[j].y * v[j].y) + (v[j].z * v[j].z + v[j].w * v[j].w); }
        const float rstd = 1.f / sqrtf(wave_sum(s2, lane) * (1.f / DM) + LN_EPS);
#pragma unroll
        for (int j = 0; j < 4; ++j) { const f32x4 y = v[j] * rstd * gv[j] + bv[j]; xr[64 * j] = y; u32x2 w; w.x = pk2(y.x, y.y); w.y = pk2(y.z, y.w); o8[64 * j] = w; }
    }
}
__device__ __forceinline__ float sq8(const u32x4 w) { const float a = pg8::bflo(w.x), b = pg8::bfhi(w.x), c = pg8::bflo(w.y), d = pg8::bfhi(w.y), e = pg8::bflo(w.z), f = pg8::bfhi(w.z), g = pg8::bflo(w.w), h = pg8::bfhi(w.w);
    return (a * a + b * b) + (c * c + d * d) + (e * e + f * f) + (g * g + h * h); }
__device__ __forceinline__ void kmean_phase(const bf16_t* QK, float* kmean, unsigned* kstat, int gw, int NGW, int lane) {
    for (int it = gw; it < NBATCH * NHEADS * 32; it += NGW) {
        const int n = it & 31, bh = it >> 5, b = bh / NHEADS, h = bh - b * NHEADS;
        const bf16_t* kp = QK + ((size_t)b * SEQ + (size_t)n * 256) * QKP + 384 + h * 64 + lane;
        float s = 0.f;
#pragma unroll 8
        for (int i = 0; i < 256; ++i) s += pg8::bf2f(kp[(size_t)i * QKP]);
        kmean[(size_t)it * 64 + lane] = s * (1.f / 256.f);
    }
    for (int it = gw; it < 2 * NBATCH * NHEADS * 128; it += NGW) {
        const int ch = it & 127, r = it >> 7, ty = r / (NBATCH * NHEADS), bh = r - ty * (NBATCH * NHEADS), b = bh / NHEADS, h = bh - b * NHEADS;
        const bf16_t* kp = QK + ((size_t)b * SEQ + (size_t)ch * 64 + lane) * QKP + (ty == 0 ? 384 : 1152) + h * 64;
        const float a0 = sq8(*(const u32x4*)(kp)) + sq8(*(const u32x4*)(kp + 8)) + sq8(*(const u32x4*)(kp + 16)) + sq8(*(const u32x4*)(kp + 24));
        const float a1 = sq8(*(const u32x4*)(kp + 32)) + sq8(*(const u32x4*)(kp + 40)) + sq8(*(const u32x4*)(kp + 48)) + sq8(*(const u32x4*)(kp + 56));
        float m0 = (ty == 0) ? a0 + a1 : a0, m1 = a1;
#pragma unroll
        for (int o = 1; o < 64; o <<= 1) { m0 = fmaxf(m0, shx(m0, o, lane)); m1 = fmaxf(m1, shx(m1, o, lane)); }
        if (lane == 0) { if (ty == 0) atomicMax(kstat + bh, __float_as_uint(m0)); else { atomicMax(kstat + 32 + 2 * bh, __float_as_uint(m0)); atomicMax(kstat + 32 + 2 * bh + 1, __float_as_uint(m1)); } }
    }
}
#define MFMA32(a, b, c) __builtin_amdgcn_mfma_f32_32x32x16_bf16((a), (b), (c), 0, 0, 0)
using pg8::cvt_pk_bf16;
__device__ __forceinline__ bf16x8 ld8(const bf16_t* p) { return *(const bf16x8*)p; }
__device__ __forceinline__ int swap23(int i) { return (i & ~12) | ((i & 4) << 1) | ((i & 8) >> 1); }
template <int ST> __device__ __forceinline__ bf16x8 pack8(const f32x16& x) {
    u32x4 p; p.x = cvt_pk_bf16(x[8 * ST + 0], x[8 * ST + 1]); p.y = cvt_pk_bf16(x[8 * ST + 2], x[8 * ST + 3]); p.z = cvt_pk_bf16(x[8 * ST + 4], x[8 * ST + 5]); p.w = cvt_pk_bf16(x[8 * ST + 6], x[8 * ST + 7]);
    return __builtin_bit_cast(bf16x8, p);
}
__device__ __forceinline__ f32x16 zero16() { f32x16 z;
#pragma unroll
    for (int r = 0; r < 16; ++r) z[r] = 0.f;
    return z; }
__device__ __forceinline__ int keyof(int r, int hi) { return 16 * (r >> 3) + 8 * hi + (r & 7); }
struct AttnP { const bf16_t* QK; const bf16_t* VT; bf16_t* O; const float* kmean; const float* dlam; const float* subg; unsigned* ctr; const unsigned* kstat; int layer; };
constexpr float NEGL2 = 44.0f;
__device__ __forceinline__ float sqsum8(const bf16x8 v) { const u32x4 w = __builtin_bit_cast(u32x4, v); return sq8(w); }

__device__ __forceinline__ void sm_update(f32x16& s, float& m, float& l, f32x16 (&o)[2], int lane) {
    float mt = fmaxf(fmaxf(s[0], s[1]), fmaxf(s[2], s[3]));
#pragma unroll
    for (int r = 4; r < 16; r += 2) mt = fmaxf(mt, fmaxf(s[r], s[r + 1]));
    mt = fmaxf(mt, shx(mt, 32, lane));
    const float mn = fmaxf(m, mt);
    const float mref = (mn == -INFINITY) ? 0.f : mn;
    const float corr = __builtin_amdgcn_exp2f(m - mref);
    m = mn;
    float ps = 0.f;
#pragma unroll
    for (int r = 0; r < 16; ++r) { s[r] = __builtin_amdgcn_exp2f(s[r] - mref); ps += s[r]; }
    l = l * corr + ps;
    if (__builtin_amdgcn_ballot_w64(corr != 1.0f) != 0ull) {
#pragma unroll
        for (int r = 0; r < 16; ++r) { o[0][r] *= corr; o[1][r] *= corr; }
    }
}
__device__ __forceinline__ void pv_acc(f32x16 (&o)[2], const bf16x8 (&v)[4], const bf16x8 p0, const bf16x8 p1) {
    o[0] = MFMA32(v[0], p0, o[0]); o[0] = MFMA32(v[1], p1, o[0]);
    o[1] = MFMA32(v[2], p0, o[1]); o[1] = MFMA32(v[3], p1, o[1]);
}
__device__ __forceinline__ void ldv(bf16x8 (&v)[4], const bf16_t* VTb, int kt0, int j, int hi) {
    const bf16_t* vp = VTb + (size_t)j * SEQ + kt0 + hi * 8;
    v[0] = ld8(vp); v[1] = ld8(vp + 16); v[2] = ld8(vp + (size_t)32 * SEQ); v[3] = ld8(vp + (size_t)32 * SEQ + 16);
}
__device__ __forceinline__ void store_o(bf16_t* orow, const f32x16 (&o)[2], int hi) {
#pragma unroll
    for (int db = 0; db < 2; ++db)
#pragma unroll
        for (int g = 0; g < 4; ++g) { u32x2 w; w.x = cvt_pk_bf16(o[db][4 * g], o[db][4 * g + 1]); w.y = cvt_pk_bf16(o[db][4 * g + 2], o[db][4 * g + 3]);
            *(u32x2*)(orow + 32 * db + 8 * g + 4 * hi) = w; }
}
template <bool DIAG> __device__ __forceinline__ f32x16 bias_init(float sl2, float dl) {
    f32x16 b; const float base = -sl2 * dl;
#pragma unroll
    for (int r = 0; r < 16; ++r) { const float ko = (float)(16 * (r >> 3) + (r & 7)); const float v = fmaf(sl2, ko, base); b[r] = (DIAG && dl < ko) ? -INFINITY : v; }
    return b;
}

__device__ __forceinline__ void moba_unit(const AttnP& p, int b, int h, int qt, int lane) {
    const int j = lane & 31, hi = lane >> 5, t0 = qt * 32, own = t0 >> 8, t = t0 + j, kr = swap23(j);
    const size_t rowb = (size_t)b * SEQ;
    const bf16_t* Qp = p.QK + (rowb + t) * QKP + h * 64;
    const bf16_t* Kb = p.QK + rowb * QKP + 384 + h * 64 + hi * 8;
    const bf16_t* VTb = p.VT + ((size_t)((0 * 4 + b) * 6 + h) * 64) * SEQ;
    bf16x8 qf[4];
#pragma unroll
    for (int ks = 0; ks < 4; ++ks) qf[ks] = ld8(Qp + ks * 16 + hi * 8);
    float qs = (sqsum8(qf[0]) + sqsum8(qf[1])) + (sqsum8(qf[2]) + sqsum8(qf[3]));
    qs += shx(qs, 32, lane);
    const float bound = sqrtf(qs) * sqrtf(__uint_as_float(p.kstat[b * NHEADS + h])) * 1.002f;
    float v0 = -INFINITY, v1 = -INFINITY, v2 = -INFINITY; int i0 = -1, i1 = -1, i2 = -1;
    if (own > 0) {
        float qv[32];
#pragma unroll
        for (int c = 0; c < 4; ++c) { const u32x4 w = *(const u32x4*)(Qp + 32 * hi + 8 * c);
            qv[8 * c + 0] = pg8::bflo(w.x); qv[8 * c + 1] = pg8::bfhi(w.x); qv[8 * c + 2] = pg8::bflo(w.y); qv[8 * c + 3] = pg8::bfhi(w.y);
            qv[8 * c + 4] = pg8::bflo(w.z); qv[8 * c + 5] = pg8::bfhi(w.z); qv[8 * c + 6] = pg8::bflo(w.w); qv[8 * c + 7] = pg8::bfhi(w.w); }
        const float* km = p.kmean + ((size_t)(b * NHEADS + h) * 32) * 64 + 32 * hi;
        for (int n = 0; n < own; ++n) {
            float g = 0.f;
#pragma unroll
            for (int c = 0; c < 8; ++c) { const f32x4 kv = *(const f32x4*)(km + n * 64 + 4 * c);
                g += qv[4 * c] * kv.x; g += qv[4 * c + 1] * kv.y; g += qv[4 * c + 2] * kv.z; g += qv[4 * c + 3] * kv.w; }
            g += shx(g, 32, lane);
            if (g > v0) { v2 = v1; i2 = i1; v1 = v0; i1 = i0; v0 = g; i0 = n; }
            else if (g > v1) { v2 = v1; i2 = i1; v1 = g; i1 = n; }
            else if (g > v2) { v2 = g; i2 = n; }
        }
    }
    const float sl2 = __builtin_amdgcn_exp2f(-8.0f * (float)(2 * h + 1) / 12.0f) * 1.4426950408889634f;
    float m = -INFINITY, l = 0.f; f32x16 o[2]; o[0] = zero16(); o[1] = zero16();
    for (int kt0 = t0; kt0 >= own * 256; kt0 -= 32) {
        const bf16_t* kp = Kb + (size_t)(kt0 + kr) * QKP;
        const bf16x8 k0 = ld8(kp), k1 = ld8(kp + 16), k2 = ld8(kp + 32), k3 = ld8(kp + 48);
        bf16x8 v[4]; ldv(v, VTb, kt0, j, hi);
        const float dl = (float)(t - kt0 - 8 * hi);
        f32x16 s = (kt0 == t0) ? bias_init<true>(sl2, dl) : bias_init<false>(sl2, dl);
        s = MFMA32(k0, qf[0], s); s = MFMA32(k1, qf[1], s); s = MFMA32(k2, qf[2], s); s = MFMA32(k3, qf[3], s);
        sm_update(s, m, l, o, lane);
        pv_acc(o, v, pack8<0>(s), pack8<1>(s));
        if (__builtin_amdgcn_ballot_w64(bound - sl2 * (float)(t - kt0 + 1) - m >= -NEGL2) == 0ull) break;
    }
    for (int n = own - 1; n >= 0; --n) {
        const bool sel = (n == i0) || (n == i1) || (n == i2);
        if (__builtin_amdgcn_ballot_w64(sel && (bound - sl2 * (float)(t - n * 256 - 255) - m >= -NEGL2)) == 0ull) continue;
        for (int kt0 = n * 256 + 224; kt0 >= n * 256; kt0 -= 32) {
            const bf16_t* kp = Kb + (size_t)(kt0 + kr) * QKP;
            const bf16x8 k0 = ld8(kp), k1 = ld8(kp + 16), k2 = ld8(kp + 32), k3 = ld8(kp + 48);
            bf16x8 v[4]; ldv(v, VTb, kt0, j, hi);
            f32x16 s = bias_init<false>(sl2, (float)(t - kt0 - 8 * hi));
            if (!sel) {
#pragma unroll
                for (int r = 0; r < 16; ++r) s[r] = -INFINITY;
            }
            s = MFMA32(k0, qf[0], s); s = MFMA32(k1, qf[1], s); s = MFMA32(k2, qf[2], s); s = MFMA32(k3, qf[3], s);
            sm_update(s, m, l, o, lane);
            pv_acc(o, v, pack8<0>(s), pack8<1>(s));
            if (__builtin_amdgcn_ballot_w64(sel && (bound - sl2 * (float)(t - kt0 + 1) - m >= -NEGL2)) == 0ull) break;
        }
    }
    l += shx(l, 32, lane);
    const float inv = 1.0f / l;
#pragma unroll
    for (int r = 0; r < 16; ++r) { o[0][r] *= inv; o[1][r] *= inv; }
    store_o(p.O + (rowb + t) * OP + 0 * 384 + h * 64, o, hi);
}

__device__ __forceinline__ void diff_unit(const AttnP& p, int b, int h, int qt, int lane, float lam, float lambda_init) {
    const int j = lane & 31, hi = lane >> 5, t0 = qt * 32, t = t0 + j, kr = swap23(j);
    const size_t rowb = (size_t)b * SEQ;
    const bf16_t* Qp = p.QK + (rowb + t) * QKP + 768 + h * 64 + hi * 8;
    const bf16_t* Kb = p.QK + rowb * QKP + 1152 + h * 64 + hi * 8;
    const bf16_t* VTb = p.VT + ((size_t)((1 * 4 + b) * 6 + h) * 64) * SEQ;
    const bf16x8 qa0 = ld8(Qp), qa1 = ld8(Qp + 16), qb0 = ld8(Qp + 32), qb1 = ld8(Qp + 48);
    float qs1 = sqsum8(qa0) + sqsum8(qa1), qs2 = sqsum8(qb0) + sqsum8(qb1);
    qs1 += shx(qs1, 32, lane); qs2 += shx(qs2, 32, lane);
    const float bound1 = sqrtf(qs1) * sqrtf(__uint_as_float(p.kstat[32 + 2 * (b * NHEADS + h)])) * 1.002f;
    const float bound2 = sqrtf(qs2) * sqrtf(__uint_as_float(p.kstat[32 + 2 * (b * NHEADS + h) + 1])) * 1.002f;
    const float sl2 = __builtin_amdgcn_exp2f(-8.0f * (float)(2 * h + 2) / 12.0f) * 1.4426950408889634f;
    float m1 = -INFINITY, l1 = 0.f, m2 = -INFINITY, l2 = 0.f;
    f32x16 o1[2], o2[2]; o1[0] = zero16(); o1[1] = zero16(); o2[0] = zero16(); o2[1] = zero16();
    for (int kt0 = t0; kt0 >= 0; kt0 -= 32) {
        const bf16_t* kp = Kb + (size_t)(kt0 + kr) * QKP;
        const bf16x8 ka0 = ld8(kp), ka1 = ld8(kp + 16), kb0 = ld8(kp + 32), kb1 = ld8(kp + 48);
        bf16x8 v[4]; ldv(v, VTb, kt0, j, hi);
        const float dl = (float)(t - kt0 - 8 * hi);
        const f32x16 bi = (kt0 == t0) ? bias_init<true>(sl2, dl) : bias_init<false>(sl2, dl);
        {
            f32x16 s1 = MFMA32(ka0, qa0, bi); s1 = MFMA32(ka1, qa1, s1);
            sm_update(s1, m1, l1, o1, lane);
            pv_acc(o1, v, pack8<0>(s1), pack8<1>(s1));
        }
        __builtin_amdgcn_sched_barrier(0);
        {
            f32x16 s2 = MFMA32(kb0, qb0, bi); s2 = MFMA32(kb1, qb1, s2);
            sm_update(s2, m2, l2, o2, lane);
            pv_acc(o2, v, pack8<0>(s2), pack8<1>(s2));
        }
        const float dn = sl2 * (float)(t - kt0 + 1);
        if (__builtin_amdgcn_ballot_w64((bound1 - dn - m1 >= -NEGL2) || (bound2 - dn - m2 >= -NEGL2)) == 0ull) break;
    }
    l1 += shx(l1, 32, lane); l2 += shx(l2, 32, lane);
    const float i1 = 1.0f / l1, i2 = lam / l2;
    float ss = 0.f;
#pragma unroll
    for (int r = 0; r < 16; ++r) { o1[0][r] = o1[0][r] * i1 - o2[0][r] * i2; o1[1][r] = o1[1][r] * i1 - o2[1][r] * i2; ss += o1[0][r] * o1[0][r] + o1[1][r] * o1[1][r]; }
    ss += shx(ss, 32, lane);
    const float rn = (1.0f / sqrtf(ss * (1.0f / 64.0f) + SUBLN_EPS)) * (1.0f - lambda_init);
#pragma unroll
    for (int db = 0; db < 2; ++db)
#pragma unroll
        for (int g = 0; g < 4; ++g) { const f32x4 gv = *(const f32x4*)(p.subg + 32 * db + 8 * g + 4 * hi);
            o1[db][4 * g] *= rn * gv.x; o1[db][4 * g + 1] *= rn * gv.y; o1[db][4 * g + 2] *= rn * gv.z; o1[db][4 * g + 3] *= rn * gv.w; }
    store_o(p.O + (rowb + t) * OP + 1 * 384 + h * 64, o1, hi);
}

__device__ __forceinline__ void sb_unit(const AttnP& p, int b, int h, int qt, int lane) {
    const int j = lane & 31, hi = lane >> 5, t0 = qt * 32, t = t0 + j, kr = swap23(j);
    const size_t rowb = (size_t)b * SEQ;
    const bf16_t* Qp = p.QK + (rowb + t) * QKP + 1536 + h * 64 + hi * 8;
    const bf16_t* Kb = p.QK + rowb * QKP + 1920 + h * 64 + hi * 8;
    const bf16_t* VTb = p.VT + ((size_t)((2 * 4 + b) * 6 + h) * 64) * SEQ;
    bf16x8 qf[4];
#pragma unroll
    for (int ks = 0; ks < 4; ++ks) qf[ks] = ld8(Qp + ks * 16);
    f32x16 o[2]; o[0] = zero16(); o[1] = zero16();
    float R = 0.f;
    for (int kt0 = t0; kt0 >= 0; kt0 -= 32) {
        const bf16_t* kp = Kb + (size_t)(kt0 + kr) * QKP;
        const bf16x8 k0 = ld8(kp), k1 = ld8(kp + 16), k2 = ld8(kp + 32), k3 = ld8(kp + 48);
        bf16x8 v[4]; ldv(v, VTb, kt0, j, hi);
        f32x16 z = zero16();
        z = MFMA32(k0, qf[0], z); z = MFMA32(k1, qf[1], z); z = MFMA32(k2, qf[2], z); z = MFMA32(k3, qf[3], z);
        f32x16 L;
        float g0 = 0.f, g1 = 0.f;
#pragma unroll
        for (int r = 0; r < 16; ++r) {
            const bool valid = (kt0 + keyof(r, hi)) < t;
            const float zz = z[r];
            const float e = __builtin_amdgcn_exp2f(-1.4426950408889634f * fabsf(zz));
            const float lg = fminf(-zz, 0.f) - 0.6931471805599453f * __builtin_amdgcn_logf(1.0f + e);
            L[r] = valid ? lg : 0.f;
            if (r < 8) g0 += L[r]; else g1 += L[r];
        }
        const float og0 = shx(g0, 32, lane), og1 = shx(g1, 32, lane);
        float run1 = R + (hi == 0 ? og1 : 0.f);
        float run0 = R + g1 + og1 + (hi == 0 ? og0 : 0.f);
#pragma unroll
        for (int e = 7; e >= 0; --e) {
            run0 += L[e];     { const bool valid = (kt0 + keyof(e, hi)) < t;     z[e]     = valid ? __builtin_amdgcn_exp2f(1.4426950408889634f * (z[e] + run0)) : 0.f; }
            run1 += L[8 + e]; { const bool valid = (kt0 + keyof(8 + e, hi)) < t; z[8 + e] = valid ? __builtin_amdgcn_exp2f(1.4426950408889634f * (z[8 + e] + run1)) : 0.f; }
        }
        pv_acc(o, v, pack8<0>(z), pack8<1>(z));
        R += (g0 + g1) + (og0 + og1);
        if (__builtin_amdgcn_ballot_w64(R > -100.0f) == 0ull) break;
    }
    store_o(p.O + (rowb + t) * OP + 2 * 384 + h * 64, o, hi);
}

__device__ __forceinline__ void attn_phase(const AttnP& p, int lane, int bx) {
    const float* lf = p.dlam;
    float pa = (lane < 32) ? lf[lane] * lf[32 + lane] : 0.f, pb = (lane < 32) ? lf[64 + lane] * lf[96 + lane] : 0.f;
    pa = wave_sum(pa, lane); pb = wave_sum(pb, lane);
    const float lambda_init = 0.8f - 0.6f * expf(-0.3f * (float)p.layer);
    const float lam = expf(pa) - expf(pb) + lambda_init;
    const int x0 = bx & 7;
    for (int k = 0; k < 8; ++k) {
        const int xq = (x0 + k) & 7;
        unsigned* ctr = p.ctr + 64 * xq;
        for (;;) {
            unsigned u = 0;
            if (lane == 0) u = atomicAdd(ctr, 1u);
            u = (unsigned)__builtin_amdgcn_readfirstlane((int)u);
            if (u >= 9u * 256u) break;
            const int seg = (int)(u >> 8), qt = 255 - (int)(u & 255u);
            const int tyo = seg / 3, bh = xq + 8 * (seg - 3 * tyo), b = bh / NHEADS, h = bh - b * NHEADS;
            if (tyo == 0) diff_unit(p, b, h, qt, lane, lam, lambda_init);
            else if (tyo == 1) moba_unit(p, b, h, qt, lane);
            else sb_unit(p, b, h, qt, lane);
        }
    }
}
#define XB_TMO      128
#define XB_XCNT(j)  (256  + 64 * (j))
#define XB_XSUB(j)  (1280 + 64 * (j))
#define XB_XGEN(j)  (2304 + 64 * (j))
#define XB_TOP      3328
#define XB_TOPGEN   3392
#define XCD_BAR_WORDS 3456
#define XB_SPIN_CAP (1u << 18)

__device__ __forceinline__ unsigned xb_ld(unsigned* p)              { return __hip_atomic_load(p, __ATOMIC_RELAXED, __HIP_MEMORY_SCOPE_AGENT); }
__device__ __forceinline__ unsigned xb_add(unsigned* p, unsigned v) { return __hip_atomic_fetch_add(p, v, __ATOMIC_RELAXED, __HIP_MEMORY_SCOPE_AGENT); }
__device__ __forceinline__ unsigned xb_xcc_id() { return (unsigned)__builtin_amdgcn_s_getreg((3 << 11) | 20) & 0xFu; }
#define XB_SPIN(cond, bar) do { unsigned _sp = 0; while (cond) { __builtin_amdgcn_s_sleep(1); \
    if ((++_sp & 255u) == 0u) { if (xb_ld(&(bar)[XB_TMO])) break; if (_sp > XB_SPIN_CAP) { atomicAdd(&(bar)[XB_TMO], 1u); break; } } } } while (0)

struct XcdBarrier {
    unsigned* bar; unsigned x;
    volatile LAS unsigned* st;
};

__device__ __forceinline__ XcdBarrier xcd_barrier_post(unsigned* bar, volatile LAS unsigned* st) {
    XcdBarrier b; b.bar = bar; b.x = xb_xcc_id(); b.st = st;
    if (threadIdx.x == 0) (void)xb_add(&bar[XB_XCNT(b.x)], 1u);
    return b;
}
__device__ __forceinline__ void xcd_barrier_complete(unsigned* bar, unsigned x, unsigned& nloc, unsigned& nx) {
    const unsigned G = gridDim.x * gridDim.y * gridDim.z;
    unsigned sum, cnt, mine, sp = 0u;
    for (;;) {
        sum = 0u; cnt = 0u; mine = 0u;
#pragma unroll
        for (unsigned j = 0; j < 16; ++j) { const unsigned c = xb_ld(&bar[XB_XCNT(j)]); sum += c; cnt += (c > 0u) ? 1u : 0u; mine = (j == x) ? c : mine; }
        if (sum == G) break;
        __builtin_amdgcn_s_sleep(1);
        if ((++sp & 255u) == 0u) { if (xb_ld(&bar[XB_TMO])) break; if (sp > XB_SPIN_CAP) { atomicAdd(&bar[XB_TMO], 1u); break; } }
    }
    nloc = mine > 0u ? mine : 1u; nx = cnt > 0u ? cnt : 1u;
}

__device__ __forceinline__ void xcd_barrier(const XcdBarrier& b) {
    asm volatile("s_waitcnt vmcnt(0)" ::: "memory");
    __syncthreads();
    if (threadIdx.x == 0) {
        unsigned* bar = b.bar;
        __builtin_amdgcn_s_waitcnt(0);
        unsigned nloc = b.st[0], nx = b.st[1];
        if (nloc == 0u) { xcd_barrier_complete(bar, b.x, nloc, nx); b.st[0] = nloc; b.st[1] = nx; }
        const unsigned old = xb_add(&bar[XB_XSUB(b.x)], 1u);
        const unsigned gen = old / nloc;
        if (old + 1u == (gen + 1u) * nloc) {
            __builtin_amdgcn_fence(__ATOMIC_RELEASE, "agent");
            asm volatile("s_waitcnt vmcnt(0)" ::: "memory");
            const unsigned og = xb_add(&bar[XB_TOP], 1u);
            const unsigned tg = og / nx;
            if (og + 1u == (tg + 1u) * nx) xb_add(&bar[XB_TOPGEN], 1u);
            else XB_SPIN(xb_ld(&bar[XB_TOPGEN]) == tg, bar);
            __builtin_amdgcn_fence(__ATOMIC_ACQUIRE, "agent");
            xb_add(&bar[XB_XGEN(b.x)], 1u);
            asm volatile("s_waitcnt vmcnt(0)" ::: "memory");
        } else {
            XB_SPIN(xb_ld(&bar[XB_XGEN(b.x)]) == gen, bar);
            __builtin_amdgcn_fence(__ATOMIC_ACQUIRE, "agent");
            asm volatile("s_waitcnt vmcnt(0)" ::: "memory");
        }
    }
    __syncthreads();
}
__global__ void __launch_bounds__(NWAVES * 64, 2) mega_fwd(Args a) {
    extern __shared__ __attribute__((aligned(16))) unsigned char lds_raw[];
    LAS unsigned char* lds = (LAS unsigned char*)lds_raw;
    cg::grid_group grid = cg::this_grid();
    const int G = gridDim.x, NGW = G * NWAVES;
    volatile LAS unsigned* bst = (volatile LAS unsigned*)(lds + pg8::STAGE_BYTES);
    if (threadIdx.x < 2) bst[threadIdx.x] = 0u;
    __syncthreads();
    XcdBarrier bar = xcd_barrier_post((unsigned*)(a.ws + WS_CTL) + CW_BAR, bst);
    grid.sync();
    const float alpha = 1.4142135623730951f;
#pragma unroll 1
    for (int ph = 0; ph < 14 * DEPTH; ++ph) {
        const int l = ph / 14, k = ph - 14 * l;
        int tid = threadIdx.x; asm volatile("" : "+v"(tid));
        int bx = blockIdx.x; asm volatile("" : "+s"(bx));
        const int lane = tid & 63, wave = __builtin_amdgcn_readfirstlane(tid >> 6), gw = bx * NWAVES + wave;
        ArgsP ap = (ArgsP)__builtin_amdgcn_kernarg_segment_ptr(); asm volatile("" : "+s"(ap));
        unsigned char* ws = ap->ws;
        bf16_t* XB = (bf16_t*)(ws + WS_XB); bf16_t* QK = (bf16_t*)(ws + WS_QK); bf16_t* VT = (bf16_t*)(ws + WS_VT); bf16_t* OB = (bf16_t*)(ws + WS_O);
        bf16_t* MG = (bf16_t*)(ws + WS_MG); bf16_t* GB = (bf16_t*)(ws + WS_G); bf16_t* HB = (bf16_t*)(ws + WS_H);
        bf16_t* Wgu = (bf16_t*)(ws + WS_WGU); bf16_t* Wd = (bf16_t*)(ws + WS_WD); bf16_t* Win = (bf16_t*)(ws + WS_WIN); bf16_t* Wbr = (bf16_t*)(ws + WS_WBR); bf16_t* Wout = (bf16_t*)(ws + WS_WOUT);
        float* kmean = (float*)(ws + WS_KMEAN); unsigned* ctl = (unsigned*)(ws + WS_CTL);
        if (k == 0) {
            p0_convert(ap, ws, l, lds, gw, NGW, wave, lane);
        } else if (k == 1 || k == 11) {
            const int f = (k == 11);
            pg8::Gemm g{XB, Wgu + (size_t)f * 5632 * 1024, M, 5632, DM, DM, DM}; pg8::StaticOrder S; S.init(M, 5632, G, bx);
            pg8::EpiSwiGLU E{HB, DFF};
            pg8::gemm_phase<pg8::EpiSwiGLU, pg8::StaticOrder, true, true>(lds, g, S, E, tid);
        } else if (k == 2 || k == 9 || k == 12) {
            pg8::Gemm g; float beta; const float* src = ap->out;
            if (k == 9) { g = pg8::Gemm{MG, Wout, M, DM, DM, DM, DM}; beta = 1.0f; }
            else { const int f = (k == 12); g = pg8::Gemm{HB, Wd + (size_t)f * 1024 * 2816, M, DM, DFF, DFF, DFF}; beta = 0.5f; if (l == 0 && k == 2) src = ap->x; }
            pg8::StaticOrder S; S.init(M, DM, G, bx);
            pg8::EpiResid E{src, ap->out, DM, alpha, beta};
            pg8::gemm_phase<pg8::EpiResid, pg8::StaticOrder, true, true>(lds, g, S, E, tid);
        } else if (k == 3 || k == 10 || k == 13) {
            const int sub = (k == 3) ? 0 : (k == 10 ? 1 : 2);
            ln_phase(ap->out, XB, ap->ln_g + (size_t)(l * 3 + sub) * DM, ap->ln_b + (size_t)(l * 3 + sub) * DM, gw, NGW, lane);
        } else if (k == 4) {
            pg8::Gemm g{XB, Win, M, NQKVP, DM, DM, DM}; pg8::StaticOrder S; S.init(M, NQKVP, G, bx);
            pg8::EpiQKV E{QK, VT};
            pg8::gemm_phase<pg8::EpiQKV, pg8::StaticOrder, true, true>(lds, g, S, E, tid);
        } else if (k == 5) {
            kmean_phase(QK, kmean, ctl + 1024 + 128 * l, gw, NGW, lane);
        } else if (k == 6) {
            AttnP p{QK, VT, OB, kmean, ap->dlam + (size_t)l * 128, ap->subg + (size_t)l * 64, ctl + 512 * l, ctl + 1024 + 128 * l, l};
            attn_phase(p, lane, bx);
        } else if (k == 7) {
            pg8::Gemm g{XB, Win + (size_t)NQKVP * 1024, M, NGATE, DM, DM, DM}; pg8::StaticOrder S; S.init(M, NGATE, G, bx);
            pg8::EpiGate E{GB, ap->b_gate + (size_t)l * NGATE};
            pg8::gemm_phase<pg8::EpiGate, pg8::StaticOrder, true, true>(lds, g, S, E, tid);
        } else if (k == 8) {
            pg8::Gemm g{OB, Wbr, M, NGATE, 384, OP, 384}; pg8::BranchOrder S{G, bx};
            pg8::EpiBranch E{MG, GB};
            pg8::gemm_phase<pg8::EpiBranch, pg8::BranchOrder, true, true>(lds, g, S, E, tid);
        }
        xcd_barrier(bar);
    }
}

extern "C" void kernel_launch(void* const* d_in, const int* in_sizes, int n_in, void* d_out, int out_size, void* d_ws, size_t ws_size, hipStream_t stream) {
    static int grid = 0;
    if (grid == 0) {
        if (n_in != 14 || in_sizes[0] != M * DM || out_size != M * DM || ws_size < WS_END) { fprintf(stderr, "kernel_launch: unexpected shapes (n_in %d, in0 %d, out %d, ws %zu)\n", n_in, n_in > 0 ? in_sizes[0] : -1, out_size, ws_size); grid = -1; return; }
        int dev = 0, cus = 0, per_cu = 0;
        if (hipGetDevice(&dev) != hipSuccess || hipDeviceGetAttribute(&cus, hipDeviceAttributeMultiprocessorCount, dev) != hipSuccess) { grid = -1; return; }
        if (hipFuncSetAttribute((const void*)mega_fwd, hipFuncAttributeMaxDynamicSharedMemorySize, LDS_BYTES) != hipSuccess) { fprintf(stderr, "kernel_launch: hipFuncSetAttribute failed\n"); grid = -1; return; }
        if (hipOccupancyMaxActiveBlocksPerMultiprocessor(&per_cu, (const void*)mega_fwd, NWAVES * 64, LDS_BYTES) != hipSuccess || per_cu < 1) { fprintf(stderr, "kernel_launch: occupancy query says %d\n", per_cu); per_cu = 1; }
        (void)hipGetLastError();
        grid = cus * per_cu;
    }
    if (grid < 0) return;
    (void)hipMemsetAsync((char*)d_ws + WS_CTL, 0, CTL_ZERO_BYTES, stream);
    Args a{};
    a.x = (const float*)d_in[0]; a.ln_g = (const float*)d_in[1]; a.ln_b = (const float*)d_in[2]; a.w_gate = (const float*)d_in[3]; a.w_up = (const float*)d_in[4];
    a.w_down = (const float*)d_in[5]; a.w_in = (const float*)d_in[6]; a.b_gate = (const float*)d_in[7]; a.dlam = (const float*)d_in[8]; a.subg = (const float*)d_in[9];
    a.w_brm = (const float*)d_in[10]; a.w_brd = (const float*)d_in[11]; a.w_brs = (const float*)d_in[12]; a.w_out = (const float*)d_in[13];
    a.out = (float*)d_out; a.ws = (unsigned char*)d_ws;
    void* args[] = {&a};
    hipError_t e = hipLaunchCooperativeKernel((const void*)mega_fwd, dim3(grid), dim3(NWAVES * 64), args, LDS_BYTES, stream);
    if (e != hipSuccess) fprintf(stderr, "kernel_launch: cooperative launch failed: %s (grid %d)\n", hipGetErrorString(e), grid);
}
```
